# Optimizing an MI355X kernel written in HIP

```python
import math
import jax, jax.numpy as jnp
from jax import lax
import numpy as np

D_MODEL = 1024
BATCH = 4
SEQ = 4096
DEPTH = 1

A_HEADS = 8
A_HEAD_DIM = 64
B_PATTERNS = ((128, 1), (512, 4), (2048, 16))
B_HEADS = 8
B_HEAD_DIM = 64
Q_BLOCK = 128
D_FF = 2816
CONV_WIDTH = 3
EPS = 1e-5
ALPHA = (2.0 * DEPTH) ** 0.25
BETA = (8.0 * DEPTH) ** -0.25

A_Q = 2 * A_HEADS * A_HEAD_DIM
A_K = 2 * A_HEADS * A_HEAD_DIM
A_V = A_HEADS * 2 * A_HEAD_DIM
B_QKV = 3 * len(B_PATTERNS) * B_HEADS * B_HEAD_DIM
GATE_COLS = 2 * D_MODEL
IN_COLS = A_Q + A_K + A_V + B_QKV + GATE_COLS
SPLITS = [A_Q, A_Q + A_K, A_Q + A_K + A_V, A_Q + A_K + A_V + B_QKV]

kernel_name = "hybrid_diffattn_dilated_deepnorm_block"


def lambda_init_fn(layer_idx):
    return 0.8 - 0.6 * math.exp(-0.3 * layer_idx)


def alibi_slopes(n):
    return jnp.asarray(np.power(np.float32(2.0), -8.0 * (np.arange(n, dtype=np.float32) + 1) / n), jnp.float32)


def layer_norm(x, g, b):
    xf = x.astype(jnp.float32)
    mu = jnp.mean(xf, axis=-1, keepdims=True)
    var = jnp.mean(jnp.square(xf - mu), axis=-1, keepdims=True)
    y = (xf - mu) * lax.rsqrt(var + EPS) * g.astype(jnp.float32) + b.astype(jnp.float32)
    return y.astype(x.dtype)


def diff_attention(q, k, v, lam, subln_w, lambda_init):
    bsz, seq = q.shape[0], q.shape[1]
    nblk = seq // Q_BLOCK
    slopes = jnp.repeat(alibi_slopes(A_HEADS), 2)
    qb = (q * A_HEAD_DIM ** -0.5).reshape(bsz, nblk, Q_BLOCK, 2 * A_HEADS, A_HEAD_DIM)
    qb = qb.transpose(1, 0, 3, 2, 4)
    kpos = jnp.arange(seq)

    def one_block(args):
        blk, qblk = args
        s = jnp.einsum('bmqd,bkmd->bmqk', qblk, k).astype(jnp.float32)
        dist = (blk * Q_BLOCK + jnp.arange(Q_BLOCK))[:, None] - kpos[None, :]
        s = jnp.where(dist >= 0, s - slopes[:, None, None] * dist, -jnp.inf)
        p = jax.nn.softmax(s, axis=-1).reshape(bsz, A_HEADS, 2, Q_BLOCK, seq)
        a = p[:, :, 0] - lam * p[:, :, 1]
        return jnp.einsum('bhqk,bkhe->bqhe', a.astype(v.dtype), v)

    o = lax.map(one_block, (jnp.arange(nblk), qb))
    o = o.transpose(1, 0, 2, 3, 4).reshape(bsz, seq, A_HEADS, 2 * A_HEAD_DIM).astype(jnp.float32)
    o = o * lax.rsqrt(jnp.mean(jnp.square(o), axis=-1, keepdims=True) + EPS)
    o = o * subln_w.astype(jnp.float32) * (1.0 - lambda_init)
    return o.reshape(bsz, seq, A_HEADS * 2 * A_HEAD_DIM).astype(q.dtype)


def dilated_group(q, k, v, slopes, window, dil):
    bsz, seq, nh, dh = q.shape
    steps = window // dil
    span = dil * steps
    s_pad = -(-seq // span) * span
    padw = ((0, 0), (0, s_pad - seq), (0, 0), (0, 0))
    q, k, v = jnp.pad(q, padw), jnp.pad(k, padw), jnp.pad(v, padw)
    nb = s_pad // span
    split = lambda t: t.reshape(bsz, nb, steps, dil, nh, dh)
    qs, ks, vs = split(q * dh ** -0.5), split(k), split(v)
    prev = lambda t: jnp.pad(t, ((0, 0), (1, 0), (0, 0), (0, 0), (0, 0), (0, 0)))[:, :-1]
    kk = jnp.concatenate([prev(ks), ks], axis=2)
    vv = jnp.concatenate([prev(vs), vs], axis=2)
    s = jnp.einsum('bnqrhd,bnkrhd->bnrhqk', qs, kk).astype(jnp.float32)
    qi = jnp.arange(steps)
    kj = jnp.arange(2 * steps)
    step = qi[:, None] + steps - kj[None, :]
    valid = ((step >= 0) & (step <= steps))[None] & \
        ((jnp.arange(nb)[:, None, None] * steps + kj[None, None, :] - steps) >= 0)
    bias = -slopes[:, None, None] * (step * dil)
    s = jnp.where(valid[None, :, None, None], s + bias, -jnp.inf)
    m = jnp.max(s, axis=-1, keepdims=True)
    e = jnp.exp(s - m)
    den = jnp.sum(e, axis=-1, keepdims=True)
    o = jnp.einsum('bnrhqk,bnkrhd->bnrhqd', e.astype(v.dtype), vv).astype(jnp.float32) / den
    lse = (m + jnp.log(den))[..., 0]
    o = o.transpose(0, 1, 4, 2, 3, 5).reshape(bsz, s_pad, nh, dh)[:, :seq]
    lse = lse.transpose(0, 1, 4, 2, 3).reshape(bsz, s_pad, nh)[:, :seq]
    return o, lse


def setup_inputs(seed: int = 0) -> dict:
    key = jax.random.key(seed)
    ks = jax.random.split(key, 20)
    f32 = jnp.float32
    nrm = lambda k, shape, scale: jax.random.normal(k, shape, f32) * scale
    col_scale = np.ones((IN_COLS,), np.float32)
    col_scale[A_Q + A_K:A_Q + A_K + A_V] = BETA
    b_v0 = A_Q + A_K + A_V + 2 * (B_QKV // 3)
    col_scale[b_v0:b_v0 + B_QKV // 3] = BETA
    w_in = nrm(ks[1], (DEPTH, D_MODEL, IN_COLS), D_MODEL ** -0.5) * jnp.asarray(col_scale)
    return {
        "x": jax.random.normal(ks[0], (BATCH, SEQ, D_MODEL), f32),
        "w_in": w_in,
        "b_gate": nrm(ks[2], (DEPTH, GATE_COLS), 0.01),
        "lambda_q1": nrm(ks[3], (DEPTH, A_HEAD_DIM), 0.1),
        "lambda_k1": nrm(ks[4], (DEPTH, A_HEAD_DIM), 0.1),
        "lambda_q2": nrm(ks[5], (DEPTH, A_HEAD_DIM), 0.1),
        "lambda_k2": nrm(ks[6], (DEPTH, A_HEAD_DIM), 0.1),
        "subln_w": 1.0 + nrm(ks[7], (DEPTH, 2 * A_HEAD_DIM), 0.01),
        "w_pa": nrm(ks[8], (DEPTH, A_V, D_MODEL), A_V ** -0.5),
        "w_pb": nrm(ks[9], (DEPTH, B_HEADS * B_HEAD_DIM, D_MODEL), (B_HEADS * B_HEAD_DIM) ** -0.5),
        "w_o": nrm(ks[10], (DEPTH, D_MODEL, D_MODEL), BETA * D_MODEL ** -0.5),
        "ln1_g": 1.0 + nrm(ks[11], (DEPTH, D_MODEL), 0.01),
        "ln1_b": nrm(ks[12], (DEPTH, D_MODEL), 0.01),
        "w_up": nrm(ks[13], (DEPTH, D_MODEL, 2 * D_FF), D_MODEL ** -0.5),
        "w_conv": nrm(ks[14], (DEPTH, CONV_WIDTH, 2 * D_FF), CONV_WIDTH ** -0.5),
        "b_conv": nrm(ks[15], (DEPTH, 2 * D_FF), 0.01),
        "w_down": nrm(ks[16], (DEPTH, D_FF, D_MODEL), BETA * D_FF ** -0.5),
        "ln2_g": 1.0 + nrm(ks[17], (DEPTH, D_MODEL), 0.01),
        "ln2_b": nrm(ks[18], (DEPTH, D_MODEL), 0.01),
    }


def reference(x, w_in, b_gate, lambda_q1, lambda_k1, lambda_q2, lambda_k2, subln_w,
              w_pa, w_pb, w_o, ln1_g, ln1_b, w_up, w_conv, b_conv, w_down, ln2_g, ln2_b):
    bsz, seq, _ = x.shape
    slopes_b = alibi_slopes(B_HEADS)
    for l in range(DEPTH):
        lambda_init = lambda_init_fn(l)
        proj = x @ w_in[l]
        qa, ka, va, pb, gl = jnp.split(proj, SPLITS, axis=-1)
        qa = qa.reshape(bsz, seq, 2 * A_HEADS, A_HEAD_DIM)
        ka = ka.reshape(bsz, seq, 2 * A_HEADS, A_HEAD_DIM)
        va = va.reshape(bsz, seq, A_HEADS, 2 * A_HEAD_DIM)
        lam = (jnp.exp(jnp.sum(lambda_q1[l].astype(jnp.float32) * lambda_k1[l].astype(jnp.float32)))
               - jnp.exp(jnp.sum(lambda_q2[l].astype(jnp.float32) * lambda_k2[l].astype(jnp.float32)))
               + lambda_init)
        oa = diff_attention(qa, ka, va, lam, subln_w[l], lambda_init)

        pb = pb.reshape(bsz, seq, 3, len(B_PATTERNS), B_HEADS, B_HEAD_DIM)
        outs, lses = [], []
        for g, (window, dil) in enumerate(B_PATTERNS):
            o, lse = dilated_group(pb[:, :, 0, g], pb[:, :, 1, g], pb[:, :, 2, g], slopes_b, window, dil)
            outs.append(o)
            lses.append(lse)
        wts = jax.nn.softmax(jnp.stack(lses), axis=0)
        ob = jnp.sum(wts[..., None] * jnp.stack(outs), axis=0)
        ob = ob.reshape(bsz, seq, B_HEADS * B_HEAD_DIM).astype(x.dtype)

        gates = jax.nn.sigmoid((gl + b_gate[l]).astype(jnp.float32)).astype(x.dtype)
        gates = gates.reshape(bsz, seq, 2, D_MODEL)
        y = gates[:, :, 0] * (oa @ w_pa[l]) + gates[:, :, 1] * (ob @ w_pb[l])
        x = layer_norm(ALPHA * x + y @ w_o[l], ln1_g[l], ln1_b[l])

        h = x @ w_up[l]
        hp = jnp.pad(h, ((0, 0), (CONV_WIDTH - 1, 0), (0, 0)))
        h = b_conv[l] + sum(hp[:, j:j + seq] * w_conv[l, j] for j in range(CONV_WIDTH))
        a, gv = jnp.split(h, 2, axis=-1)
        f = jax.nn.gelu(a, approximate=False) * gv
        x = layer_norm(ALPHA * x + f @ w_down[l], ln2_g[l], ln2_b[l])
    return x
```

```cpp
#include <hip/hip_runtime.h>
#include <hip/hip_cooperative_groups.h>
#include <cstdio>
#include <cstdint>
#include <cmath>
namespace cg = cooperative_groups;
namespace pg8 {
#define PG8_LAS __attribute__((address_space(3)))
typedef unsigned short bf16_t;
typedef short bf16x8 __attribute__((ext_vector_type(8)));
typedef float f32x4 __attribute__((ext_vector_type(4)));
typedef unsigned u32x4 __attribute__((ext_vector_type(4)));
constexpr int BM = 256, BK = 64, HALF = 128, HTB = HALF * BK * 2  , STAGE_BYTES = 8 * HTB, NXCD = 8, WGM = 8;

__host__ __device__ __forceinline__ int lds_byte(int r, int c) { const int st = (r >> 4) * 2 + (c >> 5), rr = r & 15, cc = c & 31, ob = rr * 64 + cc * 2; return st * 1024 + (ob ^ (((ob >> 9) & 1) << 5)); }
__host__ __device__ __forceinline__ void stage_rc(int b, int& R, int& C) { const int st = b / 1024, sb = b % 1024, swz = sb ^ (((sb >> 9) & 1) << 5); R = (st >> 1) * 16 + swz / 64; C = (st & 1) * 32 + (swz % 64) / 2; }
__host__ __device__ __forceinline__ int perm32(int rho) { const int n = rho >> 4, i = rho & 15; return 8 * (i >> 2) + 4 * n + (i & 3); }

struct Unit { int pm, pn; };
struct Gemm { const bf16_t* A; const bf16_t* Bt; int M, N, K, lda, ldb; };

struct StaticOrder {
    int nM, nN, nwg, G, c;
    __host__ __device__ void init(int M, int N, int G_, int c_) { nM = M / BM; nN = N / BM; nwg = nM * nN; G = G_; c = c_; }
    __host__ __device__ bool next(int i, Unit& u) const {
        const long L = (long)i * G + c; if (L >= nwg) return false;
        int wgid = (int)L; { const int q = nwg / NXCD, r = nwg % NXCD, xcd = wgid % NXCD, off = wgid / NXCD; wgid = (xcd < r ? xcd * (q + 1) : r * (q + 1) + (xcd - r) * q) + off; }
        const int nig = WGM * nN, gid = wgid / nig, fm = gid * WGM, gsz = (nM - fm) < WGM ? (nM - fm) : WGM;
        u.pm = fm + ((wgid % nig) % gsz); u.pn = (wgid % nig) / gsz; return true;
    }
    __device__ __forceinline__ void a_ready(const Unit&) const {}
    __device__ __forceinline__ void done(const Unit&) const {}
};

typedef float f32x2c_t __attribute__((ext_vector_type(2))); typedef __bf16 bf16x2c_t __attribute__((ext_vector_type(2)));
__device__ __forceinline__ unsigned cvt_pk_bf16(float lo, float hi) { f32x2c_t v = {lo, hi}; bf16x2c_t b = __builtin_convertvector(v, bf16x2c_t); return __builtin_bit_cast(unsigned, b); }
typedef float f32x2 __attribute__((ext_vector_type(2)));
__device__ __forceinline__ f32x2 gelu_pk(f32x2 v) {
    const f32x2 av = __builtin_elementwise_abs(v), d = av * 0.2316418882f + 1.0f;
    f32x2 t; t.x = __builtin_amdgcn_rcpf(d.x); t.y = __builtin_amdgcn_rcpf(d.y);
    f32x2 q = t * 0.5307027145f + (-0.7265760135f); q = q * t + 0.7107068705f; q = q * t + (-0.142248368f); q = q * t + 0.127414796f; q = q * t;
    const f32x2 s = (v * v) * (-0.72134752044f);
    f32x2 e; e.x = __builtin_amdgcn_exp2f(s.x); e.y = __builtin_amdgcn_exp2f(s.y);
    const f32x2 m = v * (q * e), r = v - m;
    f32x2 o; o.x = v.x < 0.f ? m.x : r.x; o.y = v.y < 0.f ? m.y : r.y; return o;
}
__device__ __forceinline__ float sigmoidf_(float v) { return __builtin_amdgcn_rcpf(1.0f + __builtin_amdgcn_exp2f(-1.4426950408889634f * v)); }
__device__ __forceinline__ float bf_lo(unsigned w) { return __uint_as_float(w << 16); }
__device__ __forceinline__ float bf_hi(unsigned w) { return __uint_as_float(w & 0xffff0000u); }
template <int ACT  > struct EpiStore {
    static constexpr bool PERM = true, AFTER_DRAIN = false;
    bf16_t* O; int ldc; const float* bias;
    __device__ __forceinline__ void operator()(const f32x4 (&acc)[2][2][4][2], const Unit& u, int wr, int wc, int fr, int fq) const {
        const int row0 = u.pm * BM + wr * 64 + fr; const int col0 = u.pn * BM + wc * 32 + 8 * fq;
        f32x4 bv[2][2];
#pragma unroll
        for (int bj = 0; bj < 2; ++bj)
#pragma unroll
            for (int n = 0; n < 2; ++n) bv[bj][n] = (ACT == 2) ? *(const f32x4*)(bias + col0 + bj * HALF + 4 * n) : (f32x4){0.f, 0.f, 0.f, 0.f};
#pragma unroll
        for (int ai = 0; ai < 2; ++ai)
#pragma unroll
            for (int m = 0; m < 4; ++m) { bf16_t* rowp = O + (size_t)(row0 + ai * HALF + m * 16) * ldc + col0;
#pragma unroll
                for (int bj = 0; bj < 2; ++bj) { f32x4 v0 = acc[ai][bj][m][0] + bv[bj][0], v1 = acc[ai][bj][m][1] + bv[bj][1];
                    if (ACT == 2) {
#pragma unroll
                        for (int e = 0; e < 4; ++e) { v0[e] = sigmoidf_(v0[e]); v1[e] = sigmoidf_(v1[e]); } }
                    u32x4 w; w.x = cvt_pk_bf16(v0[0], v0[1]); w.y = cvt_pk_bf16(v0[2], v0[3]); w.z = cvt_pk_bf16(v1[0], v1[1]); w.w = cvt_pk_bf16(v1[2], v1[3]);
                    *(u32x4*)(rowp + bj * HALF) = w; } }
    }
};
template <bool HAS_ADD> struct EpiMix {
    static constexpr bool PERM = true, AFTER_DRAIN = false;
    bf16_t* O; int ldc; const bf16_t* gate; int ldg; const bf16_t* add; int ldadd;
    __device__ __forceinline__ void operator()(const f32x4 (&acc)[2][2][4][2], const Unit& u, int wr, int wc, int fr, int fq) const {
        const int row0 = u.pm * BM + wr * 64 + fr; const int col0 = u.pn * BM + wc * 32 + 8 * fq;
#pragma unroll
        for (int ai = 0; ai < 2; ++ai)
#pragma unroll
            for (int m = 0; m < 4; ++m) { const size_t row = (size_t)(row0 + ai * HALF + m * 16);
#pragma unroll
                for (int bj = 0; bj < 2; ++bj) {
                    const u32x4 gw = *(const u32x4*)(gate + row * ldg + col0 + bj * HALF);
                    f32x4 v0 = acc[ai][bj][m][0], v1 = acc[ai][bj][m][1];
                    v0[0] *= bf_lo(gw.x); v0[1] *= bf_hi(gw.x); v0[2] *= bf_lo(gw.y); v0[3] *= bf_hi(gw.y);
                    v1[0] *= bf_lo(gw.z); v1[1] *= bf_hi(gw.z); v1[2] *= bf_lo(gw.w); v1[3] *= bf_hi(gw.w);
                    if (HAS_ADD) { const u32x4 aw = *(const u32x4*)(add + row * ldadd + col0 + bj * HALF);
                        v0[0] += bf_lo(aw.x); v0[1] += bf_hi(aw.x); v0[2] += bf_lo(aw.y); v0[3] += bf_hi(aw.y);
                        v1[0] += bf_lo(aw.z); v1[1] += bf_hi(aw.z); v1[2] += bf_lo(aw.w); v1[3] += bf_hi(aw.w); }
                    u32x4 w; w.x = cvt_pk_bf16(v0[0], v0[1]); w.y = cvt_pk_bf16(v0[2], v0[3]); w.z = cvt_pk_bf16(v1[0], v1[1]); w.w = cvt_pk_bf16(v1[2], v1[3]);
                    *(u32x4*)(O + row * ldc + col0 + bj * HALF) = w; } }
    }
};
template <bool BASE_BF16> struct EpiRes {
    static constexpr bool PERM = false, AFTER_DRAIN = false;
    float* Z; int ldc; const void* base; float alpha;
    __device__ __forceinline__ void operator()(const f32x4 (&acc)[2][2][4][2], const Unit& u, int wr, int wc, int fr, int fq) const {
        const int row0 = u.pm * BM + wr * 64 + fr; const int col0 = u.pn * BM + wc * 32 + 4 * fq;
#pragma unroll
        for (int ai = 0; ai < 2; ++ai)
#pragma unroll
            for (int m = 0; m < 4; ++m) { const size_t off = (size_t)(row0 + ai * HALF + m * 16) * ldc + col0;
#pragma unroll
                for (int bj = 0; bj < 2; ++bj)
#pragma unroll
                    for (int n = 0; n < 2; ++n) { const size_t o = off + bj * HALF + n * 16; f32x4 b;
                        if (BASE_BF16) { typedef unsigned u32x2v __attribute__((ext_vector_type(2))); const u32x2v w = *(const u32x2v*)((const bf16_t*)base + o); b = (f32x4){bf_lo(w.x), bf_hi(w.x), bf_lo(w.y), bf_hi(w.y)}; }
                        else b = *(const f32x4*)((const float*)base + o);
                        *(f32x4*)(Z + o) = b * alpha + acc[ai][bj][m][n]; } }
    }
};
struct GateOrder {
    StaticOrder S;
    __device__ bool next(int i, Unit& u) const { if (i >= 2) return false; if (!S.next(0, u)) return false; u.pn += 4 * i; return true; }
    __device__ __forceinline__ void a_ready(const Unit&) const {}
    __device__ __forceinline__ void done(const Unit&) const {}
};
template <class Epi, class Sched, bool ALIGN_EPI = false, bool SP2 = false>
__device__ __forceinline__ void gemm_phase(PG8_LAS unsigned char* lds, const Gemm g, const Sched& S, const Epi& E) {
    const int tid = threadIdx.x, wid = __builtin_amdgcn_readfirstlane(tid >> 6), lane = tid & 63, wr = wid >> 2, wc = wid & 3, fr = lane & 15, fq = lane >> 4;
    const int K = g.K, nt = K / BK;
    unsigned voffA[2], voffB[2];
#pragma unroll
    for (int i = 0; i < 2; ++i) { int R, C; stage_rc(tid * 16 + i * 8192, R, C); const int Rb = Epi::PERM ? ((R & ~31) + perm32(R & 31)) : R;
        voffA[i] = (unsigned)(R * g.lda + C) * 2u; voffB[i] = (unsigned)(Rb * g.ldb + C) * 2u; }
    const size_t kstep = (size_t)(BK * 2);
    const size_t hstepA = (size_t)HALF * g.lda * 2, hstepB = (size_t)HALF * g.ldb * 2;
    const size_t tstepA = 2 * hstepA, tstepB = 2 * hstepB;
    const unsigned ldsw = (unsigned)wid * 1024u;
    const int aoff = lds_byte(wr * 64 + fr, fq * 8), boff = lds_byte(wc * 32 + fr, fq * 8);
#define PG8_SA(b, h) (((b) * 2 + (h)) * HTB)
#define PG8_SB(b, h) ((4 + (b) * 2 + (h)) * HTB)
#define PG8_STAGE(bufoff, gbase, voff) do { _Pragma("unroll") for (int _i = 0; _i < 2; ++_i) \
        __builtin_amdgcn_global_load_lds((const unsigned*)((const char*)(gbase) + (voff)[_i]), (PG8_LAS unsigned*)(lds + (bufoff) + ldsw + _i * 8192), 16, 0, 0); } while (0)
#define PG8_LDA(dst, b, h) do { _Pragma("unroll") for (int m = 0; m < 4; ++m) _Pragma("unroll") for (int k = 0; k < 2; ++k) dst[m][k] = *(const PG8_LAS bf16x8*)(lds + PG8_SA(b, h) + aoff + m * 2048 + k * 1024); } while (0)
#define PG8_LDB(dst, b, h) do { _Pragma("unroll") for (int n = 0; n < 2; ++n) _Pragma("unroll") for (int k = 0; k < 2; ++k) dst[n][k] = *(const PG8_LAS bf16x8*)(lds + PG8_SB(b, h) + boff + n * 2048 + k * 1024); } while (0)
#define PG8_MMA(ai, bj, At, Bt) do { __builtin_amdgcn_s_setprio(1); _Pragma("unroll") for (int m = 0; m < 4; ++m) _Pragma("unroll") for (int n = 0; n < 2; ++n) _Pragma("unroll") for (int k = 0; k < 2; ++k) \
        acc[ai][bj][m][n] = __builtin_amdgcn_mfma_f32_16x16x32_bf16(Bt[n][k], At[m][k], acc[ai][bj][m][n], 0, 0, 0); __builtin_amdgcn_s_setprio(0); } while (0)
#define PG8_WAIT_V(n) asm volatile("s_waitcnt vmcnt(" #n ")" ::: "memory")
#define PG8_WAIT_L(n) asm volatile("s_waitcnt lgkmcnt(" #n ")" ::: "memory")
#define PG8_BAR __builtin_amdgcn_s_barrier()
#define PG8_SCHED __builtin_amdgcn_sched_barrier(0)
    Unit cur, nxt; int ui = 0;
    if (!S.next(0, cur)) return;
    f32x4 acc[2][2][4][2];
#pragma unroll
    for (int a = 0; a < 2; ++a)
#pragma unroll
        for (int b = 0; b < 2; ++b)
#pragma unroll
            for (int m = 0; m < 4; ++m)
#pragma unroll
                for (int n = 0; n < 2; ++n) acc[a][b][m][n] = (f32x4){0.f, 0.f, 0.f, 0.f};
    bf16x8 At[4][2], B0[2][2], B1[2][2];
    const char* cA = (const char*)g.A + (size_t)cur.pm * tstepA; const char* cB = (const char*)g.Bt + (size_t)cur.pn * tstepB;
    S.a_ready(cur);
    if constexpr (SP2) {
        PG8_STAGE(PG8_SB(0, 0), cB, voffB); PG8_STAGE(PG8_SB(0, 1), cB + hstepB, voffB); PG8_STAGE(PG8_SA(0, 0), cA, voffA); PG8_STAGE(PG8_SA(0, 1), cA + hstepA, voffA);
        if (wr == 1) PG8_BAR;
        PG8_WAIT_V(2); PG8_BAR;
        PG8_STAGE(PG8_SB(1, 0), cB + kstep, voffB); PG8_STAGE(PG8_SA(1, 0), cA + kstep, voffA); PG8_STAGE(PG8_SB(1, 1), cB + hstepB + kstep, voffB);
        PG8_WAIT_V(6); PG8_BAR;
    } else {
        PG8_STAGE(PG8_SB(0, 0), cB, voffB); PG8_STAGE(PG8_SA(0, 0), cA, voffA); PG8_STAGE(PG8_SB(0, 1), cB + hstepB, voffB); PG8_STAGE(PG8_SA(0, 1), cA + hstepA, voffA);
        if (wr == 1) PG8_BAR;
        PG8_WAIT_V(4); PG8_BAR;
        PG8_STAGE(PG8_SB(1, 0), cB + kstep, voffB); PG8_STAGE(PG8_SA(1, 0), cA + kstep, voffA); PG8_STAGE(PG8_SB(1, 1), cB + hstepB + kstep, voffB);
        PG8_WAIT_V(6); PG8_BAR;
    }
    for (;;) {
        const bool has_next = S.next(ui + 1, nxt);
        const char* nA = has_next ? (const char*)g.A + (size_t)nxt.pm * tstepA : cA; const char* nB = has_next ? (const char*)g.Bt + (size_t)nxt.pn * tstepB : cB;
        for (int t = 0; t < nt; t += 2) {
            const bool last = (t == nt - 2);
            const char* a1 = cA + (size_t)(t + 1) * kstep;
            const char* a2 = last ? nA : cA + (size_t)(t + 2) * kstep; const char* b2 = last ? nB : cB + (size_t)(t + 2) * kstep;
            const char* a3 = a2 + kstep; const char* b3 = b2 + kstep;
            if (last && has_next) S.a_ready(nxt);
            if constexpr (SP2) {
            PG8_LDB(B0, 0, 0); PG8_LDB(B1, 0, 1); PG8_SCHED; PG8_LDA(At, 0, 0); PG8_STAGE(PG8_SA(1, 1), a1 + hstepA, voffA);
            PG8_WAIT_V(8); PG8_WAIT_L(0); PG8_BAR; PG8_MMA(0, 0, At, B0); PG8_MMA(0, 1, At, B1); PG8_BAR; PG8_SCHED;
            PG8_LDA(At, 0, 1); PG8_STAGE(PG8_SB(0, 0), b2, voffB); PG8_STAGE(PG8_SB(0, 1), b2 + hstepB, voffB); PG8_STAGE(PG8_SA(0, 0), a2, voffA);
            PG8_WAIT_V(8); PG8_WAIT_L(0); PG8_BAR; PG8_MMA(1, 0, At, B0); PG8_MMA(1, 1, At, B1); PG8_BAR; PG8_SCHED;
            PG8_LDB(B0, 1, 0); PG8_LDB(B1, 1, 1); PG8_SCHED; PG8_LDA(At, 1, 0); PG8_STAGE(PG8_SA(0, 1), a2 + hstepA, voffA);
            PG8_WAIT_V(8); PG8_WAIT_L(0); PG8_BAR; PG8_MMA(0, 0, At, B0); PG8_MMA(0, 1, At, B1); PG8_BAR; PG8_SCHED;
            PG8_LDA(At, 1, 1); PG8_STAGE(PG8_SB(1, 0), b3, voffB); PG8_STAGE(PG8_SB(1, 1), b3 + hstepB, voffB); PG8_STAGE(PG8_SA(1, 0), a3, voffA);
            PG8_WAIT_V(8); PG8_WAIT_L(0); PG8_BAR; PG8_MMA(1, 0, At, B0); PG8_MMA(1, 1, At, B1); PG8_BAR; PG8_SCHED;
            } else {
            PG8_LDB(B0, 0, 0); PG8_SCHED; PG8_LDA(At, 0, 0); PG8_STAGE(PG8_SA(1, 1), a1 + hstepA, voffA);
            PG8_WAIT_L(8); PG8_BAR; PG8_WAIT_L(0); PG8_MMA(0, 0, At, B0); PG8_BAR; PG8_SCHED;
            PG8_LDB(B1, 0, 1); PG8_STAGE(PG8_SB(0, 0), b2, voffB);
            PG8_BAR; PG8_WAIT_L(0); PG8_MMA(0, 1, At, B1); PG8_BAR;
            PG8_LDA(At, 0, 1); PG8_STAGE(PG8_SA(0, 0), a2, voffA);
            PG8_BAR; PG8_WAIT_L(0); PG8_MMA(1, 0, At, B0); PG8_BAR; PG8_SCHED;
            PG8_STAGE(PG8_SB(0, 1), b2 + hstepB, voffB);
            PG8_WAIT_V(6); PG8_BAR; PG8_MMA(1, 1, At, B1); PG8_BAR;
            PG8_LDB(B0, 1, 0); PG8_SCHED; PG8_LDA(At, 1, 0); PG8_STAGE(PG8_SA(0, 1), a2 + hstepA, voffA);
            PG8_WAIT_L(8); PG8_BAR; PG8_WAIT_L(0); PG8_MMA(0, 0, At, B0); PG8_BAR; PG8_SCHED;
            PG8_LDB(B1, 1, 1); PG8_STAGE(PG8_SB(1, 0), b3, voffB);
            PG8_BAR; PG8_WAIT_L(0); PG8_MMA(0, 1, At, B1); PG8_BAR;
            PG8_LDA(At, 1, 1); PG8_STAGE(PG8_SA(1, 0), a3, voffA);
            PG8_BAR; PG8_WAIT_L(0); PG8_MMA(1, 0, At, B0); PG8_BAR; PG8_SCHED;
            PG8_STAGE(PG8_SB(1, 1), b3 + hstepB, voffB);
            PG8_WAIT_V(6); PG8_BAR; PG8_MMA(1, 1, At, B1); PG8_BAR;
            }
        }
        if constexpr (ALIGN_EPI) { if (wr == 0) PG8_BAR; }
        if constexpr (!Epi::AFTER_DRAIN) { E(acc, cur, wr, wc, fr, fq); S.done(cur); }
        if (!has_next) break;
#pragma unroll
        for (int a = 0; a < 2; ++a)
#pragma unroll
            for (int b = 0; b < 2; ++b)
#pragma unroll
                for (int m = 0; m < 4; ++m)
#pragma unroll
                    for (int n = 0; n < 2; ++n) acc[a][b][m][n] = (f32x4){0.f, 0.f, 0.f, 0.f};
        cur = nxt; cA = nA; cB = nB; ++ui;
        if constexpr (ALIGN_EPI) { if (wr == 1) PG8_BAR; }
    }
    PG8_WAIT_V(0);
    if constexpr (!ALIGN_EPI) { if (wr == 0) PG8_BAR; }
    PG8_BAR;
    if constexpr (Epi::AFTER_DRAIN) { E.fused(acc, cur, wr, wc, fr, fq, lds, wid, lane); S.done(cur); }
#undef PG8_SA
#undef PG8_SB
#undef PG8_STAGE
#undef PG8_LDA
#undef PG8_LDB
#undef PG8_MMA
#undef PG8_WAIT_V
#undef PG8_WAIT_L
#undef PG8_BAR
#undef PG8_SCHED
}
}
using pg8::bf16_t; using pg8::f32x4; using pg8::u32x4;
#define LAS __attribute__((address_space(3)))
typedef short bf16x8 __attribute__((ext_vector_type(8)));
typedef short s16x4 __attribute__((ext_vector_type(4)));
typedef float f32x16 __attribute__((ext_vector_type(16)));
typedef float f32x2 __attribute__((ext_vector_type(2)));
typedef unsigned u32x2 __attribute__((ext_vector_type(2)));
constexpr int BATCH = 4, SEQ = 4096, DM = 1024, MTOK = BATCH * SEQ, DFF = 2816, NUP = 2 * DFF;
constexpr int LDP = 6656;
constexpr int C_QA = 0, C_KA = 1024, C_QB = 2048, C_KB = 3584, C_VB = 5120, C_GATE = 3584;
constexpr float LOG2E = 1.4426950408889634f, LN_EPS = 1e-5f, ALPHA = 1.189207115002721f, QSCALE = 0.125f * LOG2E;
constexpr size_t MiB = 1u << 20;
constexpr size_t WS_WALL = 1 * MiB, WS_WPA = 20 * MiB, WS_WPB = 22 * MiB, WS_WO = 23 * MiB, WS_WUP = 25 * MiB, WS_WDN = 36 * MiB, WS_P1 = 42 * MiB;
constexpr size_t WS_Z = WS_P1, WS_F = WS_P1, WS_H = WS_P1 + 88 * MiB, WS_Z2 = WS_P1 + 88 * MiB, WS_END = 250 * MiB;
constexpr size_t OUT_XB = 0, OUT_VAT = 32 * MiB, OUT_Y = 32 * MiB, OUT_X1B = 0;
constexpr int LDS_BYTES = 160 * 1024;
constexpr int NWAVES = 8, NTHR = 512;

__device__ __forceinline__ int crow(int r, int hi) { return (r & 3) + 8 * (r >> 2) + 4 * hi; }
__device__ __forceinline__ unsigned cvtpk(float lo, float hi) { return pg8::cvt_pk_bf16(lo, hi); }
__device__ __forceinline__ float ex2(float v) { return __builtin_amdgcn_exp2f(v); }
__device__ __forceinline__ float wave_sum(float v) {
#pragma unroll
    for (int o = 1; o < 64; o <<= 1) v += __shfl_xor(v, o);
    return v;
}
#define MFMA32(a, b, c) __builtin_amdgcn_mfma_f32_32x32x16_bf16((a), (b), (c), 0, 0, 0)

__device__ __forceinline__ void transpose_item(const float* W, int K, int N, int c0, int ncols, bf16_t* WT, int row_off, float scale, LAS float* scr, int item, int lane) {
    const int nblk = ncols / 32, kb = item / nblk, nb = item % nblk, k0 = 64 * kb, n0 = 32 * nb;
#pragma unroll 8
    for (int i = 0; i < 32; ++i) { const int kk = 2 * i + (lane >> 5); scr[kk * 33 + (lane & 31)] = W[(size_t)(k0 + kk) * N + c0 + n0 + (lane & 31)] * scale; }
    asm volatile("s_waitcnt lgkmcnt(0)" ::: "memory");
    const int c = lane & 7;
#pragma unroll
    for (int j = 0; j < 4; ++j) { const int n = (lane >> 3) + 8 * j; const LAS float* s = scr + (8 * c) * 33 + n;
        u32x4 o; o.x = cvtpk(s[0 * 33], s[1 * 33]); o.y = cvtpk(s[2 * 33], s[3 * 33]); o.z = cvtpk(s[4 * 33], s[5 * 33]); o.w = cvtpk(s[6 * 33], s[7 * 33]);
        *(u32x4*)(WT + (size_t)(row_off + n0 + n) * K + k0 + 8 * c) = o; }
    asm volatile("s_waitcnt lgkmcnt(0)" ::: "memory");
}
struct Ptrs {
    const float *x, *w_in, *b_gate, *lq1, *lk1, *lq2, *lk2, *subln, *w_pa, *w_pb, *w_o, *ln1g, *ln1b, *w_up, *w_conv, *b_conv, *w_down, *ln2g, *ln2b;
    float* out; unsigned char* ws; int ph_lo, ph_hi;
};
__device__ __forceinline__ void p0_prep(const Ptrs& P, LAS unsigned char* lds, int vcu, int G, int wave, int lane, int tid) {
    LAS float* scr = (LAS float*)(lds + wave * 16384);
    const int gw = vcu * NWAVES + wave, NGW = G * NWAVES;
    bf16_t* WALL = (bf16_t*)(P.ws + WS_WALL);
    constexpr int NITEMS = 10368;
    for (int it = gw; it < NITEMS; it += NGW) {
        int r = it;
#define SEG(W, K, N, c0, nc, WT, ro, sc) { constexpr int n_ = ((K) / 64) * ((nc) / 32); if (r < n_) { transpose_item(W, K, N, c0, nc, WT, ro, sc, scr, r, lane); continue; } r -= n_; }
        SEG(P.w_in, 1024, 9728, 0, 1024, WALL, 0, QSCALE)
        SEG(P.w_in, 1024, 9728, 1024, 1024, WALL, 1024, 1.f)
        SEG(P.w_in, 1024, 9728, 2048, 1024, WALL, 6656, 1.f)
        SEG(P.w_in, 1024, 9728, 3072, 1536, WALL, 2048, QSCALE)
        SEG(P.w_in, 1024, 9728, 4608, 1536, WALL, 3584, 1.f)
        SEG(P.w_in, 1024, 9728, 6144, 1536, WALL, 5120, 1.f)
        SEG(P.w_in, 1024, 9728, 7680, 2048, WALL, 7680, 1.f)
        SEG(P.w_pa, 1024, 1024, 0, 1024, (bf16_t*)(P.ws + WS_WPA), 0, 1.f)
        SEG(P.w_pb, 512, 1024, 0, 1024, (bf16_t*)(P.ws + WS_WPB), 0, 1.f)
        SEG(P.w_o, 1024, 1024, 0, 1024, (bf16_t*)(P.ws + WS_WO), 0, 1.f)
        SEG(P.w_up, 1024, 5632, 0, 5632, (bf16_t*)(P.ws + WS_WUP), 0, 1.f)
        SEG(P.w_down, 2816, 1024, 0, 1024, (bf16_t*)(P.ws + WS_WDN), 0, 1.f)
#undef SEG
    }
    bf16_t* XB = (bf16_t*)((unsigned char*)P.out + OUT_XB);
    const size_t n8 = (size_t)MTOK * DM / 8;
    for (size_t i = (size_t)vcu * NTHR + tid; i < n8; i += (size_t)G * NTHR) {
        const f32x4 a = *(const f32x4*)(P.x + i * 8), b = *(const f32x4*)(P.x + i * 8 + 4);
        u32x4 o; o.x = cvtpk(a[0], a[1]); o.y = cvtpk(a[2], a[3]); o.z = cvtpk(b[0], b[1]); o.w = cvtpk(b[2], b[3]);
        *(u32x4*)(XB + i * 8) = o;
    }
}

namespace attA {
constexpr int KP = 272, VP = 144, KBUF = 64 * KP, VBUF = 128 * VP, BUF = KBUF + VBUF, XOFF = 2 * BUF, XP = 132;
static_assert(XOFF + 128 * XP * 4 <= LDS_BYTES, "attA lds");
__device__ __forceinline__ void unit(LAS unsigned char* lds, bf16_t* P1, const bf16_t* vaT, int b, int h, int qblk, float lam, const float* subln_w) {
    const int tid = threadIdx.x, lane = tid & 63, wid = __builtin_amdgcn_readfirstlane(tid >> 6), r32 = lane & 31, hi = lane >> 5;
    const int mi = wid >> 2, qs = wid & 3;
    const int qrow = qblk * 128 + qs * 32 + r32;
    const size_t rowbase = (size_t)b * SEQ;
    bf16x8 qf[4];
    { const bf16_t* qp = P1 + (rowbase + qrow) * LDP + C_QA + (2 * h + mi) * 64 + hi * 8;
#pragma unroll
      for (int ks = 0; ks < 4; ++ks) qf[ks] = *(const bf16x8*)(qp + ks * 16); }
    const float sl2 = ex2(-(float)(h + 1)) * LOG2E;
    f32x16 cb;
#pragma unroll
    for (int r = 0; r < 16; ++r) cb[r] = sl2 * (float)crow(r, hi);
    f32x16 O[4];
#pragma unroll
    for (int d = 0; d < 4; ++d)
#pragma unroll
        for (int r = 0; r < 16; ++r) O[d][r] = 0.f;
    float m = -INFINITY, l = 0.f;
    const int NT = 2 * qblk + 2;
    const int krow = tid >> 4, kch = tid & 15, vrow = tid >> 3, vch = tid & 7;
    const bf16_t* ksrc = P1 + (rowbase + krow) * LDP + C_KA + h * 128 + kch * 8;
    const bf16_t* vsrc = vaT + (size_t)(h * 128 + vrow) * MTOK + rowbase + vch * 8;
    const unsigned kdst = krow * KP + kch * 16, vdst = KBUF + vrow * VP + vch * 16;
    u32x4 kr0, kr1, vr0, vr1;
#define LOADT(j) { const size_t ko = (size_t)(64 * (j)) * LDP; kr0 = *(const u32x4*)(ksrc + ko); kr1 = *(const u32x4*)(ksrc + ko + (size_t)32 * LDP); \
                   vr0 = *(const u32x4*)(vsrc + 64 * (j)); vr1 = *(const u32x4*)(vsrc + (size_t)64 * MTOK + 64 * (j)); }
#define STORET(bo) { *(LAS u32x4*)(lds + (bo) + kdst) = kr0; *(LAS u32x4*)(lds + (bo) + kdst + 32 * KP) = kr1; *(LAS u32x4*)(lds + (bo) + vdst) = vr0; *(LAS u32x4*)(lds + (bo) + vdst + 64 * VP) = vr1; }
    LOADT(0); STORET(0); __syncthreads();
    for (int j = 0; j < NT; ++j) {
        const bool more = (j + 1 < NT);
        if (more) LOADT(j + 1);
        const LAS unsigned char* kb = lds + (j & 1) * BUF; const LAS unsigned char* vb = kb + KBUF;
        f32x16 S0 = cb, S1 = cb;
#pragma unroll
        for (int ks = 0; ks < 4; ++ks) {
            const bf16x8 a0 = *(const LAS bf16x8*)(kb + r32 * KP + mi * 128 + ks * 32 + hi * 16);
            const bf16x8 a1 = *(const LAS bf16x8*)(kb + (r32 + 32) * KP + mi * 128 + ks * 32 + hi * 16);
            S0 = MFMA32(a0, qf[ks], S0); S1 = MFMA32(a1, qf[ks], S1);
        }
        const int kv0 = 64 * j;
        if (j >= NT - 2) {
#pragma unroll
            for (int r = 0; r < 16; ++r) { const int kv = kv0 + crow(r, hi); if (kv > qrow) S0[r] = -INFINITY; if (kv + 32 > qrow) S1[r] = -INFINITY; }
        }
        const float tb0 = sl2 * (float)(kv0 - qrow), tb1 = tb0 + sl2 * 32.f;
        float mx0 = S0[0], mx1 = S1[0];
#pragma unroll
        for (int r = 1; r < 16; ++r) { mx0 = fmaxf(mx0, S0[r]); mx1 = fmaxf(mx1, S1[r]); }
        float mt = fmaxf(mx0 + tb0, mx1 + tb1); mt = fmaxf(mt, __shfl_xor(mt, 32));
        const float mn = fmaxf(m, mt); const float alpha = ex2(m - mn); m = mn;
        const float c0 = tb0 - mn, c1 = tb1 - mn;
        float ps = 0.f;
#pragma unroll
        for (int r = 0; r < 16; ++r) { S0[r] = ex2(S0[r] + c0); S1[r] = ex2(S1[r] + c1); ps += S0[r] + S1[r]; }
        l = l * alpha + ps;
#pragma unroll
        for (int d = 0; d < 4; ++d) O[d] = O[d] * alpha;
        u32x4 pk[2][2];
#pragma unroll
        for (int s = 0; s < 2; ++s) {
            pk[0][s] = (u32x4){cvtpk(S0[8 * s + 0], S0[8 * s + 1]), cvtpk(S0[8 * s + 2], S0[8 * s + 3]), cvtpk(S0[8 * s + 4], S0[8 * s + 5]), cvtpk(S0[8 * s + 6], S0[8 * s + 7])};
            pk[1][s] = (u32x4){cvtpk(S1[8 * s + 0], S1[8 * s + 1]), cvtpk(S1[8 * s + 2], S1[8 * s + 3]), cvtpk(S1[8 * s + 4], S1[8 * s + 5]), cvtpk(S1[8 * s + 6], S1[8 * s + 7])};
        }
#pragma unroll
        for (int d = 0; d < 4; ++d)
#pragma unroll
            for (int t2 = 0; t2 < 2; ++t2)
#pragma unroll
                for (int s = 0; s < 2; ++s) {
                    const LAS unsigned char* vp = vb + (d * 32 + r32) * VP + (t2 * 32 + s * 16 + hi * 4) * 2;
                    const s16x4 lo = *(const LAS s16x4*)vp, hh = *(const LAS s16x4*)(vp + 16);
                    const bf16x8 vf = (bf16x8){lo[0], lo[1], lo[2], lo[3], hh[0], hh[1], hh[2], hh[3]};
                    O[d] = MFMA32(vf, __builtin_bit_cast(bf16x8, pk[t2][s]), O[d]);
                }
        if (more) STORET(((j + 1) & 1) * BUF);
        __syncthreads();
    }
#undef LOADT
#undef STORET
    const float lt = l + __shfl_xor(l, 32); const float inv = 1.f / lt;
    LAS float* X = (LAS float*)(lds + XOFF);
    const int ql = qs * 32 + r32;
    if (mi == 1) { const float sc = inv * lam;
#pragma unroll
        for (int d = 0; d < 4; ++d)
#pragma unroll
            for (int g4 = 0; g4 < 4; ++g4) { const f32x4 v = (f32x4){O[d][4 * g4], O[d][4 * g4 + 1], O[d][4 * g4 + 2], O[d][4 * g4 + 3]} * sc;
                *(LAS f32x4*)(X + ql * XP + d * 32 + g4 * 8 + hi * 4) = v; } }
    __syncthreads();
    if (mi == 0) { float ss = 0.f;
#pragma unroll
        for (int d = 0; d < 4; ++d)
#pragma unroll
            for (int g4 = 0; g4 < 4; ++g4) { const f32x4 xv = *(const LAS f32x4*)(X + ql * XP + d * 32 + g4 * 8 + hi * 4);
#pragma unroll
                for (int e = 0; e < 4; ++e) { const float dv = O[d][4 * g4 + e] * inv - xv[e]; O[d][4 * g4 + e] = dv; ss += dv * dv; } }
        ss += __shfl_xor(ss, 32);
        const float rinv = rsqrtf(ss * (1.f / 128.f) + LN_EPS) * 0.8f;
        bf16_t* op = P1 + (rowbase + qrow) * LDP + C_QA + h * 128;
#pragma unroll
        for (int d = 0; d < 4; ++d)
#pragma unroll
            for (int g4 = 0; g4 < 4; ++g4) { const int d0 = d * 32 + g4 * 8 + hi * 4; const f32x4 w = *(const f32x4*)(subln_w + d0);
                u32x2 o; o.x = cvtpk(O[d][4 * g4] * rinv * w[0], O[d][4 * g4 + 1] * rinv * w[1]); o.y = cvtpk(O[d][4 * g4 + 2] * rinv * w[2], O[d][4 * g4 + 3] * rinv * w[3]);
                *(u32x2*)(op + d0) = o; } }
    __syncthreads();
}
}

namespace attB {
__device__ __forceinline__ void unit(LAS unsigned char* lds, bf16_t* P1, int b, int h, int chunk) {
    LAS float* Os = (LAS float*)lds; LAS float* Ms = (LAS float*)(lds + 131072); LAS float* Ls = Ms + 512;
    const int tid = threadIdx.x, lane = tid & 63, wid = __builtin_amdgcn_readfirstlane(tid >> 6), r32 = lane & 31, hi = lane >> 5;
    const int t0 = chunk * 512; const size_t rowbase = (size_t)b * SEQ;
    const float sl2 = ex2(-(float)(h + 1)) * LOG2E;
    for (int g = 0; g < 3; ++g) {
        const int sh = 2 * g; const float sd = sl2 * (float)(1 << sh);
        f32x16 cb;
#pragma unroll
        for (int r = 0; r < 16; ++r) cb[r] = sd * (float)crow(r, hi);
        for (int wt = wid; wt < 16; wt += 8) {
            const int cls = wt >> (4 - sh), sub = wt & ((16 >> sh) - 1);
            const int i0 = (t0 >> sh) + 32 * sub, iq = i0 + r32, tq = (iq << sh) + cls;
            bf16x8 qf[4];
            { const bf16_t* qp = P1 + (rowbase + tq) * LDP + C_QB + g * 512 + h * 64 + hi * 8;
#pragma unroll
              for (int ks = 0; ks < 4; ++ks) qf[ks] = *(const bf16x8*)(qp + ks * 16); }
            f32x16 O[2];
#pragma unroll
            for (int r = 0; r < 16; ++r) { O[0][r] = 0.f; O[1][r] = 0.f; }
            float m = -INFINITY, l = 0.f;
            for (int kb = 0; kb < 5; ++kb) {
                const int ib = i0 - 128 + 32 * kb; if (ib < 0) continue;
                const int tk = ((ib + r32) << sh) + cls;
                const bf16_t* kp = P1 + (rowbase + tk) * LDP + C_KB + g * 512 + h * 64 + hi * 8;
                f32x16 S = cb;
#pragma unroll
                for (int ks = 0; ks < 4; ++ks) S = MFMA32(*(const bf16x8*)(kp + ks * 16), qf[ks], S);
                if (kb == 0) {
#pragma unroll
                    for (int r = 0; r < 16; ++r) { const int ik = ib + crow(r, hi); if (iq - ik > 128) S[r] = -INFINITY; } }
                if (kb == 4) {
#pragma unroll
                    for (int r = 0; r < 16; ++r) { const int ik = ib + crow(r, hi); if (ik > iq) S[r] = -INFINITY; } }
                const float tb = sd * (float)(ib - iq);
                float mx = S[0];
#pragma unroll
                for (int r = 1; r < 16; ++r) mx = fmaxf(mx, S[r]);
                float mt = mx + tb; mt = fmaxf(mt, __shfl_xor(mt, 32));
                const float mn = fmaxf(m, mt); const float alpha = ex2(m - mn); m = mn; const float c = tb - mn;
                float ps = 0.f;
#pragma unroll
                for (int r = 0; r < 16; ++r) { S[r] = ex2(S[r] + c); ps += S[r]; }
                l = l * alpha + ps; O[0] = O[0] * alpha; O[1] = O[1] * alpha;
                u32x4 pk[2];
#pragma unroll
                for (int s = 0; s < 2; ++s) pk[s] = (u32x4){cvtpk(S[8 * s + 0], S[8 * s + 1]), cvtpk(S[8 * s + 2], S[8 * s + 3]), cvtpk(S[8 * s + 4], S[8 * s + 5]), cvtpk(S[8 * s + 6], S[8 * s + 7])};
                const bf16_t* vbase = P1 + rowbase * LDP + C_VB + g * 512 + h * 64 + r32;
#pragma unroll
                for (int d = 0; d < 2; ++d)
#pragma unroll
                    for (int s = 0; s < 2; ++s) {
                        bf16x8 vf;
#pragma unroll
                        for (int j = 0; j < 8; ++j) { const int kvl = 16 * s + 8 * (j >> 2) + 4 * hi + (j & 3); const int tok = ((ib + kvl) << sh) + cls;
                            vf[j] = (short)vbase[(size_t)tok * LDP + d * 32]; }
                        O[d] = MFMA32(vf, __builtin_bit_cast(bf16x8, pk[s]), O[d]);
                    }
            }
            const float lt = l + __shfl_xor(l, 32); const int tl = tq - t0;
            float a_new = 1.f, a_old = 0.f, Ln = lt;
            if (g > 0) { const float mo = Ms[tl], lo = Ls[tl]; const float mn = fmaxf(mo, m); a_old = ex2(mo - mn); a_new = ex2(m - mn); Ln = lo * a_old + lt * a_new; m = mn; }
            if (g < 2 && hi == 0) { Ms[tl] = m; Ls[tl] = Ln; }
            const float invL = 1.f / Ln;
            bf16_t* op = P1 + (rowbase + tq) * LDP + C_QB + h * 64;
#pragma unroll
            for (int d = 0; d < 2; ++d)
#pragma unroll
                for (int g4 = 0; g4 < 4; ++g4) { const int ch = 2 * g4 + hi + 8 * d; LAS f32x4* p = (LAS f32x4*)(Os + tl * 64 + ((ch ^ (tl & 15)) << 2));
                    f32x4 v = (f32x4){O[d][4 * g4], O[d][4 * g4 + 1], O[d][4 * g4 + 2], O[d][4 * g4 + 3]} * a_new;
                    if (g > 0) v = v + (*p) * a_old;
                    if (g < 2) *p = v;
                    else { v = v * invL; u32x2 o; o.x = cvtpk(v[0], v[1]); o.y = cvtpk(v[2], v[3]); *(u32x2*)(op + ch * 4) = o; } }
        }
        __syncthreads();
    }
}
}

__device__ __forceinline__ void ln_rows(const float* Z, const float* gam, const float* bet, bf16_t* outb, float* outf, int gw, int NGW, int lane) {
    for (int mrow = gw; mrow < MTOK; mrow += NGW) {
        const f32x4* zr = (const f32x4*)(Z + (size_t)mrow * DM) + lane;
        f32x4 v[4]; float s = 0.f;
#pragma unroll
        for (int j = 0; j < 4; ++j) { v[j] = zr[64 * j]; s += (v[j][0] + v[j][1]) + (v[j][2] + v[j][3]); }
        const float mean = wave_sum(s) * (1.f / DM); float s2 = 0.f;
#pragma unroll
        for (int j = 0; j < 4; ++j) { v[j] = v[j] - mean; s2 += (v[j][0] * v[j][0] + v[j][1] * v[j][1]) + (v[j][2] * v[j][2] + v[j][3] * v[j][3]); }
        const float rstd = rsqrtf(wave_sum(s2) * (1.f / DM) + LN_EPS);
#pragma unroll
        for (int j = 0; j < 4; ++j) { const int c = 4 * (lane + 64 * j); const f32x4 g4 = *(const f32x4*)(gam + c), b4 = *(const f32x4*)(bet + c);
            const f32x4 o = v[j] * rstd * g4 + b4;
            if (outb) { u32x2 w; w.x = cvtpk(o[0], o[1]); w.y = cvtpk(o[2], o[3]); *(u32x2*)(outb + (size_t)mrow * DM + c) = w; }
            if (outf) *(f32x4*)(outf + (size_t)mrow * DM + c) = o; }
    }
}

__device__ __forceinline__ void unpack8(const u32x4 w, float (&f)[8]) {
    f[0] = pg8::bf_lo(w.x); f[1] = pg8::bf_hi(w.x); f[2] = pg8::bf_lo(w.y); f[3] = pg8::bf_hi(w.y); f[4] = pg8::bf_lo(w.z); f[5] = pg8::bf_hi(w.z); f[6] = pg8::bf_lo(w.w); f[7] = pg8::bf_hi(w.w); }
__device__ __forceinline__ void conv_geglu_half(const bf16_t* H, bf16_t* F, const float* wc, const float* bc, int half, int gt, int NGT) {
    constexpr int NCC = DFF / 8, RUN = 16, NITEM = (MTOK / 2 / RUN) * NCC;
    for (int it = gt; it < NITEM; it += NGT) {
        const int rc = it / NCC, cc = it % NCC, r0 = rc * RUN, c = cc * 8;
        float w0a[8], w1a[8], w2a[8], ba[8], w0g[8], w1g[8], w2g[8], bg[8];
#pragma unroll
        for (int e = 0; e < 8; ++e) { w0a[e] = wc[c + e]; w1a[e] = wc[NUP + c + e]; w2a[e] = wc[2 * NUP + c + e]; ba[e] = bc[c + e];
            w0g[e] = wc[DFF + c + e]; w1g[e] = wc[NUP + DFF + c + e]; w2g[e] = wc[2 * NUP + DFF + c + e]; bg[e] = bc[DFF + c + e]; }
        float p2a[8], p1a[8], p2g[8], p1g[8];
        if ((r0 & (SEQ - 1)) == 0) {
#pragma unroll
            for (int e = 0; e < 8; ++e) { p2a[e] = 0.f; p1a[e] = 0.f; p2g[e] = 0.f; p1g[e] = 0.f; }
        } else {
            unpack8(*(const u32x4*)(H + (size_t)(r0 - 2) * NUP + c), p2a); unpack8(*(const u32x4*)(H + (size_t)(r0 - 1) * NUP + c), p1a);
            unpack8(*(const u32x4*)(H + (size_t)(r0 - 2) * NUP + DFF + c), p2g); unpack8(*(const u32x4*)(H + (size_t)(r0 - 1) * NUP + DFF + c), p1g);
        }
#pragma unroll 4
        for (int i = 0; i < RUN; ++i) {
            float ca[8], cgv[8];
            unpack8(*(const u32x4*)(H + (size_t)(r0 + i) * NUP + c), ca); unpack8(*(const u32x4*)(H + (size_t)(r0 + i) * NUP + DFF + c), cgv);
            float o[8];
#pragma unroll
            for (int e = 0; e < 8; e += 2) {
                const f32x2 av = (f32x2){ba[e] + w0a[e] * p2a[e] + w1a[e] * p1a[e] + w2a[e] * ca[e], ba[e + 1] + w0a[e + 1] * p2a[e + 1] + w1a[e + 1] * p1a[e + 1] + w2a[e + 1] * ca[e + 1]};
                const f32x2 ge = pg8::gelu_pk(av);
                o[e] = ge.x * (bg[e] + w0g[e] * p2g[e] + w1g[e] * p1g[e] + w2g[e] * cgv[e]);
                o[e + 1] = ge.y * (bg[e + 1] + w0g[e + 1] * p2g[e + 1] + w1g[e + 1] * p1g[e + 1] + w2g[e + 1] * cgv[e + 1]);
            }
            u32x4 w; w.x = cvtpk(o[0], o[1]); w.y = cvtpk(o[2], o[3]); w.z = cvtpk(o[4], o[5]); w.w = cvtpk(o[6], o[7]);
            *(u32x4*)(F + (size_t)(half * (MTOK / 2) + r0 + i) * DFF + c) = w;
#pragma unroll
            for (int e = 0; e < 8; ++e) { p2a[e] = p1a[e]; p1a[e] = ca[e]; p2g[e] = p1g[e]; p1g[e] = cgv[e]; }
        }
    }
}

#ifndef MK_SPLIT
#define MK_SPLIT 0
#endif
constexpr int NPHASE = 12;
__global__ void __launch_bounds__(NTHR, 2) fwd_kernel(Ptrs P) {
    extern __shared__ __attribute__((aligned(16))) unsigned char lds_raw[];
    LAS unsigned char* lds = (LAS unsigned char*)lds_raw;
    const int tid = threadIdx.x, lane = tid & 63, wave = __builtin_amdgcn_readfirstlane(tid >> 6);
    const int G = gridDim.x, bx = blockIdx.x;
    const int vcu = (G % 8 == 0) ? (bx % 8) * (G / 8) + bx / 8 : bx;
    unsigned char* ws = P.ws; unsigned char* ob = (unsigned char*)P.out;
    bf16_t* WALL = (bf16_t*)(ws + WS_WALL); bf16_t* P1 = (bf16_t*)(ws + WS_P1);
    bf16_t* XB = (bf16_t*)(ob + OUT_XB); bf16_t* VAT = (bf16_t*)(ob + OUT_VAT); bf16_t* Y = (bf16_t*)(ob + OUT_Y); bf16_t* X1B = (bf16_t*)(ob + OUT_X1B);
    const int lo = P.ph_lo, hi = P.ph_hi;
#ifndef PHMASK
#define PHMASK 0xfff
#endif
#define IN(k) (((PHMASK >> (k)) & 1) && lo <= (k) && (k) < hi)
#if MK_SPLIT
#define SEAM(k) do {} while (0)
#else
#define SEAM(k) do { if (IN(k) && IN((k) + 1)) cg::this_grid().sync(); } while (0)
#endif
    using namespace pg8;
    if (IN(0)) { p0_prep(P, lds, vcu, G, wave, lane, tid); }
    SEAM(0);
    if (IN(1)) {
        { Gemm g{XB, WALL, MTOK, LDP, DM, DM, DM}; StaticOrder S; S.init(MTOK, LDP, G, bx);
          EpiStore<0> E{P1, LDP, nullptr};
          gemm_phase<EpiStore<0>, StaticOrder, true, true>(lds, g, S, E); }
        { Gemm g{WALL + (size_t)6656 * DM, XB, 1024, MTOK, DM, DM, DM}; StaticOrder S; S.init(1024, MTOK, G, bx);
          EpiStore<0> E{VAT, MTOK, nullptr};
          gemm_phase<EpiStore<0>, StaticOrder, true, true>(lds, g, S, E); }
    }
    SEAM(1);
    if (IN(2)) {
        float lam;
        { const float a = P.lq1[lane] * P.lk1[lane], b2 = P.lq2[lane] * P.lk2[lane]; lam = expf(wave_sum(a)) - expf(wave_sum(b2)) + 0.2f; }
        __syncthreads();
#ifndef NO_ATTA
#pragma unroll 1
        for (int k = 0; k < 4; ++k) { const int p = vcu + 256 * (k >> 1); if (p < 512) { const int bh = p >> 4, i = (k & 1) ? 31 - (p & 15) : (p & 15);
            attA::unit(lds, P1, VAT, bh >> 3, bh & 7, i, lam, P.subln); } }
#endif
#ifndef NO_ATTB
#pragma unroll 1
        for (int u = vcu; u < 256; u += G) attB::unit(lds, P1, u >> 6, (u >> 3) & 7, u & 7);
#endif
    }
    SEAM(2);
    if (IN(3)) {
        { Gemm g{XB, WALL + (size_t)7680 * DM, MTOK, 2048, DM, DM, DM}; GateOrder S; S.S.init(MTOK, DM, G, bx);
          EpiStore<2> E{P1 + C_GATE, LDP, P.b_gate};
          gemm_phase<EpiStore<2>, GateOrder, true, true>(lds, g, S, E); }
        asm volatile("s_waitcnt vmcnt(0)" ::: "memory"); __syncthreads();
        { Gemm g{P1 + C_QA, (const bf16_t*)(ws + WS_WPA), MTOK, DM, 1024, LDP, 1024}; StaticOrder S; S.init(MTOK, DM, G, bx);
          EpiMix<false> E{Y, DM, P1 + C_GATE, LDP, nullptr, 0};
          gemm_phase<EpiMix<false>, StaticOrder, true, true>(lds, g, S, E); }
        asm volatile("s_waitcnt vmcnt(0)" ::: "memory"); __syncthreads();
        { Gemm g{P1 + C_QB, (const bf16_t*)(ws + WS_WPB), MTOK, DM, 512, LDP, 512}; StaticOrder S; S.init(MTOK, DM, G, bx);
          EpiMix<true> E{Y, DM, P1 + C_GATE + 1024, LDP, Y, DM};
          gemm_phase<EpiMix<true>, StaticOrder, true, true>(lds, g, S, E); }
    }
    SEAM(3);
    if (IN(4)) {
        Gemm g{Y, (const bf16_t*)(ws + WS_WO), MTOK, DM, DM, DM, DM}; StaticOrder S; S.init(MTOK, DM, G, bx);
        EpiRes<false> E{(float*)(ws + WS_Z), DM, P.x, ALPHA};
        gemm_phase<EpiRes<false>, StaticOrder, true, true>(lds, g, S, E);
    }
    SEAM(4);
    if (IN(5)) { ln_rows((const float*)(ws + WS_Z), P.ln1g, P.ln1b, X1B, nullptr, vcu * NWAVES + wave, G * NWAVES, lane); }
    SEAM(5);
#pragma unroll 1
    for (int half = 0; half < 2; ++half) {
        if (IN(6 + 2 * half)) {
            Gemm g{X1B + (size_t)half * (MTOK / 2) * DM, (const bf16_t*)(ws + WS_WUP), MTOK / 2, NUP, DM, DM, DM}; StaticOrder S; S.init(MTOK / 2, NUP, G, bx);
            EpiStore<0> E{(bf16_t*)(ws + WS_H), NUP, nullptr};
            gemm_phase<EpiStore<0>, StaticOrder, true, true>(lds, g, S, E);
        }
        SEAM(6 + 2 * half);
        if (IN(7 + 2 * half)) { conv_geglu_half((const bf16_t*)(ws + WS_H), (bf16_t*)(ws + WS_F), P.w_conv, P.b_conv, half, vcu * NTHR + tid, G * NTHR); }
        SEAM(7 + 2 * half);
    }
    if (IN(10)) {
        Gemm g{(const bf16_t*)(ws + WS_F), (const bf16_t*)(ws + WS_WDN), MTOK, DM, DFF, DFF, DFF}; StaticOrder S; S.init(MTOK, DM, G, bx);
        EpiRes<true> E{(float*)(ws + WS_Z2), DM, X1B, ALPHA};
        gemm_phase<EpiRes<true>, StaticOrder, true, true>(lds, g, S, E);
    }
    SEAM(10);
    if (IN(11)) { ln_rows((const float*)(ws + WS_Z2), P.ln2g, P.ln2b, nullptr, P.out, vcu * NWAVES + wave, G * NWAVES, lane); }
#undef IN
#undef SEAM
}

extern "C" void kernel_launch(void* const* d_in, const int* in_sizes, int n_in, void* d_out, int out_size, void* d_ws, size_t ws_size, hipStream_t stream) {
    static int grid = 0;
    if (grid == 0) {
        if (n_in != 19 || out_size != MTOK * DM || ws_size < WS_END) { fprintf(stderr, "kernel_launch: unexpected shapes (n_in %d out %d ws %zu)\n", n_in, out_size, ws_size); grid = -1; return; }
        int dev = 0, cus = 0, per_cu = 0;
        hipGetDevice(&dev); hipDeviceGetAttribute(&cus, hipDeviceAttributeMultiprocessorCount, dev);
        if (hipFuncSetAttribute((const void*)fwd_kernel, hipFuncAttributeMaxDynamicSharedMemorySize, LDS_BYTES) != hipSuccess) { fprintf(stderr, "kernel_launch: hipFuncSetAttribute failed\n"); grid = -1; return; }
        if (hipOccupancyMaxActiveBlocksPerMultiprocessor(&per_cu, (const void*)fwd_kernel, NTHR, LDS_BYTES) != hipSuccess || per_cu < 1) { fprintf(stderr, "kernel_launch: occupancy query gives %d\n", per_cu); per_cu = 1; }
        (void)hipGetLastError();
        grid = cus * 1;
        if (grid > 256) grid = 256;
    }
    if (grid < 0) return;
    Ptrs p{};
    const float** pp = (const float**)&p;
    for (int i = 0; i < 19; ++i) pp[i] = (const float*)d_in[i];
    p.out = (float*)d_out; p.ws = (unsigned char*)d_ws;
#if MK_SPLIT
    for (int k = 0; k < NPHASE; ++k) { p.ph_lo = k; p.ph_hi = k + 1; hipLaunchKernelGGL(fwd_kernel, dim3(grid), dim3(NTHR), LDS_BYTES, stream, p); }
#else
    p.ph_lo = 0; p.ph_hi = NPHASE;
    void* args[] = {&p};
    hipError_t e = hipLaunchCooperativeKernel((const void*)fwd_kernel, dim3(grid), dim3(NTHR), args, LDS_BYTES, stream);
    if (e != hipSuccess) fprintf(stderr, "cooperative launch failed: %s (grid %d)\n", hipGetErrorString(e), grid);
#endif
}
```

```cpp
#include <hip/hip_runtime.h>
#include <hip/hip_cooperative_groups.h>
#include <cstdio>
#include <cstdint>
#include <cmath>
namespace cg = cooperative_groups;
namespace pg8 {
#define PG8_LAS __attribute__((address_space(3)))
typedef unsigned short bf16_t;
typedef short bf16x8 __attribute__((ext_vector_type(8)));
typedef float f32x4 __attribute__((ext_vector_type(4)));
typedef unsigned u32x4 __attribute__((ext_vector_type(4)));
constexpr int BM = 256, BK = 64, HALF = 128, HTB = HALF * BK * 2  , STAGE_BYTES = 8 * HTB, NXCD = 8, WGM = 8;

__host__ __device__ __forceinline__ int lds_byte(int r, int c) { const int st = (r >> 4) * 2 + (c >> 5), rr = r & 15, cc = c & 31, ob = rr * 64 + cc * 2; return st * 1024 + (ob ^ (((ob >> 9) & 1) << 5)); }
__host__ __device__ __forceinline__ void stage_rc(int b, int& R, int& C) { const int st = b / 1024, sb = b % 1024, swz = sb ^ (((sb >> 9) & 1) << 5); R = (st >> 1) * 16 + swz / 64; C = (st & 1) * 32 + (swz % 64) / 2; }
__host__ __device__ __forceinline__ int perm32(int rho) { const int n = rho >> 4, i = rho & 15; return 8 * (i >> 2) + 4 * n + (i & 3); }

struct Unit { int pm, pn; };
struct Gemm { const bf16_t* A; const bf16_t* Bt; int M, N, K, lda, ldb; };

struct StaticOrder {
    int nM, nN, nwg, G, c;
    __host__ __device__ void init(int M, int N, int G_, int c_) { nM = M / BM; nN = N / BM; nwg = nM * nN; G = G_; c = c_; }
    __host__ __device__ bool next(int i, Unit& u) const {
        const long L = (long)i * G + c; if (L >= nwg) return false;
        int wgid = (int)L; { const int q = nwg / NXCD, r = nwg % NXCD, xcd = wgid % NXCD, off = wgid / NXCD; wgid = (xcd < r ? xcd * (q + 1) : r * (q + 1) + (xcd - r) * q) + off; }
        const int nig = WGM * nN, gid = wgid / nig, fm = gid * WGM, gsz = (nM - fm) < WGM ? (nM - fm) : WGM;
        u.pm = fm + ((wgid % nig) % gsz); u.pn = (wgid % nig) / gsz; return true;
    }
    __device__ __forceinline__ void a_ready(const Unit&) const {}
    __device__ __forceinline__ void done(const Unit&) const {}
};

typedef float f32x2c_t __attribute__((ext_vector_type(2))); typedef __bf16 bf16x2c_t __attribute__((ext_vector_type(2)));
__device__ __forceinline__ unsigned cvt_pk_bf16(float lo, float hi) { f32x2c_t v = {lo, hi}; bf16x2c_t b = __builtin_convertvector(v, bf16x2c_t); return __builtin_bit_cast(unsigned, b); }
typedef float f32x2 __attribute__((ext_vector_type(2)));
__device__ __forceinline__ f32x2 gelu_pk(f32x2 v) {
    const f32x2 av = __builtin_elementwise_abs(v), d = av * 0.2316418882f + 1.0f;
    f32x2 t; t.x = __builtin_amdgcn_rcpf(d.x); t.y = __builtin_amdgcn_rcpf(d.y);
    f32x2 q = t * 0.5307027145f + (-0.7265760135f); q = q * t + 0.7107068705f; q = q * t + (-0.142248368f); q = q * t + 0.127414796f; q = q * t;
    const f32x2 s = (v * v) * (-0.72134752044f);
    f32x2 e; e.x = __builtin_amdgcn_exp2f(s.x); e.y = __builtin_amdgcn_exp2f(s.y);
    const f32x2 m = v * (q * e), r = v - m;
    f32x2 o; o.x = v.x < 0.f ? m.x : r.x; o.y = v.y < 0.f ? m.y : r.y; return o;
}
__device__ __forceinline__ float sigmoidf_(float v) { return __builtin_amdgcn_rcpf(1.0f + __builtin_amdgcn_exp2f(-1.4426950408889634f * v)); }
__device__ __forceinline__ float bf_lo(unsigned w) { return __uint_as_float(w << 16); }
__device__ __forceinline__ float bf_hi(unsigned w) { return __uint_as_float(w & 0xffff0000u); }
template <int ACT  > struct EpiStore {
    static constexpr bool PERM = true, AFTER_DRAIN = false;
    bf16_t* O; int ldc; const float* bias;
    __device__ __forceinline__ void operator()(const f32x4 (&acc)[2][2][4][2], const Unit& u, int wr, int wc, int fr, int fq) const {
        const int row0 = u.pm * BM + wr * 64 + fr; const int col0 = u.pn * BM + wc * 32 + 8 * fq;
        f32x4 bv[2][2];
#pragma unroll
        for (int bj = 0; bj < 2; ++bj)
#pragma unroll
            for (int n = 0; n < 2; ++n) bv[bj][n] = (ACT == 2) ? *(const f32x4*)(bias + col0 + bj * HALF + 4 * n) : (f32x4){0.f, 0.f, 0.f, 0.f};
#pragma unroll
        for (int ai = 0; ai < 2; ++ai)
#pragma unroll
            for (int m = 0; m < 4; ++m) { bf16_t* rowp = O + (size_t)(row0 + ai * HALF + m * 16) * ldc + col0;
#pragma unroll
                for (int bj = 0; bj < 2; ++bj) { f32x4 v0 = acc[ai][bj][m][0] + bv[bj][0], v1 = acc[ai][bj][m][1] + bv[bj][1];
                    if (ACT == 2) {
#pragma unroll
                        for (int e = 0; e < 4; ++e) { v0[e] = sigmoidf_(v0[e]); v1[e] = sigmoidf_(v1[e]); } }
                    u32x4 w; w.x = cvt_pk_bf16(v0[0], v0[1]); w.y = cvt_pk_bf16(v0[2], v0[3]); w.z = cvt_pk_bf16(v1[0], v1[1]); w.w = cvt_pk_bf16(v1[2], v1[3]);
                    *(u32x4*)(rowp + bj * HALF) = w; } }
    }
};
template <bool HAS_ADD> struct EpiMix {
    static constexpr bool PERM = true, AFTER_DRAIN = false;
    bf16_t* O; int ldc; const bf16_t* gate; int ldg; const bf16_t* add; int ldadd;
    __device__ __forceinline__ void operator()(const f32x4 (&acc)[2][2][4][2], const Unit& u, int wr, int wc, int fr, int fq) const {
        const int row0 = u.pm * BM + wr * 64 + fr; const int col0 = u.pn * BM + wc * 32 + 8 * fq;
#pragma unroll
        for (int ai = 0; ai < 2; ++ai)
#pragma unroll
            for (int m = 0; m < 4; ++m) { const size_t row = (size_t)(row0 + ai * HALF + m * 16);
#pragma unroll
                for (int bj = 0; bj < 2; ++bj) {
                    const u32x4 gw = *(const u32x4*)(gate + row * ldg + col0 + bj * HALF);
                    f32x4 v0 = acc[ai][bj][m][0], v1 = acc[ai][bj][m][1];
                    v0[0] *= bf_lo(gw.x); v0[1] *= bf_hi(gw.x); v0[2] *= bf_lo(gw.y); v0[3] *= bf_hi(gw.y);
                    v1[0] *= bf_lo(gw.z); v1[1] *= bf_hi(gw.z); v1[2] *= bf_lo(gw.w); v1[3] *= bf_hi(gw.w);
                    if (HAS_ADD) { const u32x4 aw = *(const u32x4*)(add + row * ldadd + col0 + bj * HALF);
                        v0[0] += bf_lo(aw.x); v0[1] += bf_hi(aw.x); v0[2] += bf_lo(aw.y); v0[3] += bf_hi(aw.y);
                        v1[0] += bf_lo(aw.z); v1[1] += bf_hi(aw.z); v1[2] += bf_lo(aw.w); v1[3] += bf_hi(aw.w); }
                    u32x4 w; w.x = cvt_pk_bf16(v0[0], v0[1]); w.y = cvt_pk_bf16(v0[2], v0[3]); w.z = cvt_pk_bf16(v1[0], v1[1]); w.w = cvt_pk_bf16(v1[2], v1[3]);
                    *(u32x4*)(O + row * ldc + col0 + bj * HALF) = w; } }
    }
};
template <bool BASE_BF16> struct EpiRes {
    static constexpr bool PERM = false, AFTER_DRAIN = false;
    float* Z; int ldc; const void* base; float alpha;
    __device__ __forceinline__ void operator()(const f32x4 (&acc)[2][2][4][2], const Unit& u, int wr, int wc, int fr, int fq) const {
        const int row0 = u.pm * BM + wr * 64 + fr; const int col0 = u.pn * BM + wc * 32 + 4 * fq;
#pragma unroll
        for (int ai = 0; ai < 2; ++ai)
#pragma unroll
            for (int m = 0; m < 4; ++m) { const size_t off = (size_t)(row0 + ai * HALF + m * 16) * ldc + col0;
#pragma unroll
                for (int bj = 0; bj < 2; ++bj)
#pragma unroll
                    for (int n = 0; n < 2; ++n) { const size_t o = off + bj * HALF + n * 16; f32x4 b;
                        if (BASE_BF16) { typedef unsigned u32x2v __attribute__((ext_vector_type(2))); const u32x2v w = *(const u32x2v*)((const bf16_t*)base + o); b = (f32x4){bf_lo(w.x), bf_hi(w.x), bf_lo(w.y), bf_hi(w.y)}; }
                        else b = *(const f32x4*)((const float*)base + o);
                        *(f32x4*)(Z + o) = b * alpha + acc[ai][bj][m][n]; } }
    }
};
struct GateOrder {
    StaticOrder S;
    __device__ bool next(int i, Unit& u) const { if (i >= 2) return false; if (!S.next(0, u)) return false; u.pn += 4 * i; return true; }
    __device__ __forceinline__ void a_ready(const Unit&) const {}
    __device__ __forceinline__ void done(const Unit&) const {}
};
template <class Epi, class Sched, bool ALIGN_EPI = false, bool SP2 = false>
__device__ __forceinline__ void gemm_phase(PG8_LAS unsigned char* lds, const Gemm g, const Sched& S, const Epi& E) {
    const int tid = threadIdx.x, wid = __builtin_amdgcn_readfirstlane(tid >> 6), lane = tid & 63, wr = wid >> 2, wc = wid & 3, fr = lane & 15, fq = lane >> 4;
    const int K = g.K, nt = K / BK;
    unsigned voffA[2], voffB[2];
#pragma unroll
    for (int i = 0; i < 2; ++i) { int R, C; stage_rc(tid * 16 + i * 8192, R, C); const int Rb = Epi::PERM ? ((R & ~31) + perm32(R & 31)) : R;
        voffA[i] = (unsigned)(R * g.lda + C) * 2u; voffB[i] = (unsigned)(Rb * g.ldb + C) * 2u; }
    const size_t kstep = (size_t)(BK * 2);
    const size_t hstepA = (size_t)HALF * g.lda * 2, hstepB = (size_t)HALF * g.ldb * 2;
    const size_t tstepA = 2 * hstepA, tstepB = 2 * hstepB;
    const unsigned ldsw = (unsigned)wid * 1024u;
    const int aoff = lds_byte(wr * 64 + fr, fq * 8), boff = lds_byte(wc * 32 + fr, fq * 8);
#define PG8_SA(b, h) (((b) * 2 + (h)) * HTB)
#define PG8_SB(b, h) ((4 + (b) * 2 + (h)) * HTB)
#define PG8_STAGE(bufoff, gbase, voff) do { _Pragma("unroll") for (int _i = 0; _i < 2; ++_i) \
        __builtin_amdgcn_global_load_lds((const unsigned*)((const char*)(gbase) + (voff)[_i]), (PG8_LAS unsigned*)(lds + (bufoff) + ldsw + _i * 8192), 16, 0, 0); } while (0)
#define PG8_LDA(dst, b, h) do { _Pragma("unroll") for (int m = 0; m < 4; ++m) _Pragma("unroll") for (int k = 0; k < 2; ++k) dst[m][k] = *(const PG8_LAS bf16x8*)(lds + PG8_SA(b, h) + aoff + m * 2048 + k * 1024); } while (0)
#define PG8_LDB(dst, b, h) do { _Pragma("unroll") for (int n = 0; n < 2; ++n) _Pragma("unroll") for (int k = 0; k < 2; ++k) dst[n][k] = *(const PG8_LAS bf16x8*)(lds + PG8_SB(b, h) + boff + n * 2048 + k * 1024); } while (0)
#define PG8_MMA(ai, bj, At, Bt) do { __builtin_amdgcn_s_setprio(1); _Pragma("unroll") for (int m = 0; m < 4; ++m) _Pragma("unroll") for (int n = 0; n < 2; ++n) _Pragma("unroll") for (int k = 0; k < 2; ++k) \
        acc[ai][bj][m][n] = __builtin_amdgcn_mfma_f32_16x16x32_bf16(Bt[n][k], At[m][k], acc[ai][bj][m][n], 0, 0, 0); __builtin_amdgcn_s_setprio(0); } while (0)
#define PG8_WAIT_V(n) asm volatile("s_waitcnt vmcnt(" #n ")" ::: "memory")
#define PG8_WAIT_L(n) asm volatile("s_waitcnt lgkmcnt(" #n ")" ::: "memory")
#define PG8_BAR __builtin_amdgcn_s_barrier()
#define PG8_SCHED __builtin_amdgcn_sched_barrier(0)
    Unit cur, nxt; int ui = 0;
    if (!S.next(0, cur)) return;
    f32x4 acc[2][2][4][2];
#pragma unroll
    for (int a = 0; a < 2; ++a)
#pragma unroll
        for (int b = 0; b < 2; ++b)
#pragma unroll
            for (int m = 0; m < 4; ++m)
#pragma unroll
                for (int n = 0; n < 2; ++n) acc[a][b][m][n] = (f32x4){0.f, 0.f, 0.f, 0.f};
    bf16x8 At[4][2], B0[2][2], B1[2][2];
    const char* cA = (const char*)g.A + (size_t)cur.pm * tstepA; const char* cB = (const char*)g.Bt + (size_t)cur.pn * tstepB;
    S.a_ready(cur);
    if constexpr (SP2) {
        PG8_STAGE(PG8_SB(0, 0), cB, voffB); PG8_STAGE(PG8_SB(0, 1), cB + hstepB, voffB); PG8_STAGE(PG8_SA(0, 0), cA, voffA); PG8_STAGE(PG8_SA(0, 1), cA + hstepA, voffA);
        if (wr == 1) PG8_BAR;
        PG8_WAIT_V(2); PG8_BAR;
        PG8_STAGE(PG8_SB(1, 0), cB + kstep, voffB); PG8_STAGE(PG8_SA(1, 0), cA + kstep, voffA); PG8_STAGE(PG8_SB(1, 1), cB + hstepB + kstep, voffB);
        PG8_WAIT_V(6); PG8_BAR;
    } else {
        PG8_STAGE(PG8_SB(0, 0), cB, voffB); PG8_STAGE(PG8_SA(0, 0), cA, voffA); PG8_STAGE(PG8_SB(0, 1), cB + hstepB, voffB); PG8_STAGE(PG8_SA(0, 1), cA + hstepA, voffA);
        if (wr == 1) PG8_BAR;
        PG8_WAIT_V(4); PG8_BAR;
        PG8_STAGE(PG8_SB(1, 0), cB + kstep, voffB); PG8_STAGE(PG8_SA(1, 0), cA + kstep, voffA); PG8_STAGE(PG8_SB(1, 1), cB + hstepB + kstep, voffB);
        PG8_WAIT_V(6); PG8_BAR;
    }
    for (;;) {
        const bool has_next = S.next(ui + 1, nxt);
        const char* nA = has_next ? (const char*)g.A + (size_t)nxt.pm * tstepA : cA; const char* nB = has_next ? (const char*)g.Bt + (size_t)nxt.pn * tstepB : cB;
        for (int t = 0; t < nt; t += 2) {
            const bool last = (t == nt - 2);
            const char* a1 = cA + (size_t)(t + 1) * kstep;
            const char* a2 = last ? nA : cA + (size_t)(t + 2) * kstep; const char* b2 = last ? nB : cB + (size_t)(t + 2) * kstep;
            const char* a3 = a2 + kstep; const char* b3 = b2 + kstep;
            if (last && has_next) S.a_ready(nxt);
            if constexpr (SP2) {
            PG8_LDB(B0, 0, 0); PG8_LDB(B1, 0, 1); PG8_SCHED; PG8_LDA(At, 0, 0); PG8_STAGE(PG8_SA(1, 1), a1 + hstepA, voffA);
            PG8_WAIT_V(8); PG8_WAIT_L(0); PG8_BAR; PG8_MMA(0, 0, At, B0); PG8_MMA(0, 1, At, B1); PG8_BAR; PG8_SCHED;
            PG8_LDA(At, 0, 1); PG8_STAGE(PG8_SB(0, 0), b2, voffB); PG8_STAGE(PG8_SB(0, 1), b2 + hstepB, voffB); PG8_STAGE(PG8_SA(0, 0), a2, voffA);
            PG8_WAIT_V(8); PG8_WAIT_L(0); PG8_BAR; PG8_MMA(1, 0, At, B0); PG8_MMA(1, 1, At, B1); PG8_BAR; PG8_SCHED;
            PG8_LDB(B0, 1, 0); PG8_LDB(B1, 1, 1); PG8_SCHED; PG8_LDA(At, 1, 0); PG8_STAGE(PG8_SA(0, 1), a2 + hstepA, voffA);
            PG8_WAIT_V(8); PG8_WAIT_L(0); PG8_BAR; PG8_MMA(0, 0, At, B0); PG8_MMA(0, 1, At, B1); PG8_BAR; PG8_SCHED;
            PG8_LDA(At, 1, 1); PG8_STAGE(PG8_SB(1, 0), b3, voffB); PG8_STAGE(PG8_SB(1, 1), b3 + hstepB, voffB); PG8_STAGE(PG8_SA(1, 0), a3, voffA);
            PG8_WAIT_V(8); PG8_WAIT_L(0); PG8_BAR; PG8_MMA(1, 0, At, B0); PG8_MMA(1, 1, At, B1); PG8_BAR; PG8_SCHED;
            } else {
            PG8_LDB(B0, 0, 0); PG8_SCHED; PG8_LDA(At, 0, 0); PG8_STAGE(PG8_SA(1, 1), a1 + hstepA, voffA);
            PG8_WAIT_L(8); PG8_BAR; PG8_WAIT_L(0); PG8_MMA(0, 0, At, B0); PG8_BAR; PG8_SCHED;
            PG8_LDB(B1, 0, 1); PG8_STAGE(PG8_SB(0, 0), b2, voffB);
            PG8_BAR; PG8_WAIT_L(0); PG8_MMA(0, 1, At, B1); PG8_BAR;
            PG8_LDA(At, 0, 1); PG8_STAGE(PG8_SA(0, 0), a2, voffA);
            PG8_BAR; PG8_WAIT_L(0); PG8_MMA(1, 0, At, B0); PG8_BAR; PG8_SCHED;
            PG8_STAGE(PG8_SB(0, 1), b2 + hstepB, voffB);
            PG8_WAIT_V(6); PG8_BAR; PG8_MMA(1, 1, At, B1); PG8_BAR;
            PG8_LDB(B0, 1, 0); PG8_SCHED; PG8_LDA(At, 1, 0); PG8_STAGE(PG8_SA(0, 1), a2 + hstepA, voffA);
            PG8_WAIT_L(8); PG8_BAR; PG8_WAIT_L(0); PG8_MMA(0, 0, At, B0); PG8_BAR; PG8_SCHED;
            PG8_LDB(B1, 1, 1); PG8_STAGE(PG8_SB(1, 0), b3, voffB);
            PG8_BAR; PG8_WAIT_L(0); PG8_MMA(0, 1, At, B1); PG8_BAR;
            PG8_LDA(At, 1, 1); PG8_STAGE(PG8_SA(1, 0), a3, voffA);
            PG8_BAR; PG8_WAIT_L(0); PG8_MMA(1, 0, At, B0); PG8_BAR; PG8_SCHED;
            PG8_STAGE(PG8_SB(1, 1), b3 + hstepB, voffB);
            PG8_WAIT_V(6); PG8_BAR; PG8_MMA(1, 1, At, B1); PG8_BAR;
            }
        }
        if constexpr (ALIGN_EPI) { if (wr == 0) PG8_BAR; }
        if constexpr (!Epi::AFTER_DRAIN) { E(acc, cur, wr, wc, fr, fq); S.done(cur); }
        if (!has_next) break;
#pragma unroll
        for (int a = 0; a < 2; ++a)
#pragma unroll
            for (int b = 0; b < 2; ++b)
#pragma unroll
                for (int m = 0; m < 4; ++m)
#pragma unroll
                    for (int n = 0; n < 2; ++n) acc[a][b][m][n] = (f32x4){0.f, 0.f, 0.f, 0.f};
        cur = nxt; cA = nA; cB = nB; ++ui;
        if constexpr (ALIGN_EPI) { if (wr == 1) PG8_BAR; }
    }
    PG8_WAIT_V(0);
    if constexpr (!ALIGN_EPI) { if (wr == 0) PG8_BAR; }
    PG8_BAR;
    if constexpr (Epi::AFTER_DRAIN) { E.fused(acc, cur, wr, wc, fr, fq, lds, wid, lane); S.done(cur); }
#undef PG8_SA
#undef PG8_SB
#undef PG8_STAGE
#undef PG8_LDA
#undef PG8_LDB
#undef PG8_MMA
#undef PG8_WAIT_V
#undef PG8_WAIT_L
#undef PG8_BAR
#undef PG8_SCHED
}
}
using pg8::bf16_t; using pg8::f32x4; using pg8::u32x4;
#define LAS __attribute__((address_space(3)))
#define GAS __attribute__((address_space(1)))
#define XB_TMO      128
#define XB_XCNT(j)  (256  + 64 * (j))
#define XB_XSUB(j)  (1280 + 64 * (j))
#define XB_XGEN(j)  (2304 + 64 * (j))
#define XB_TOP      3328
#define XB_TOPGEN   3392
#define XCD_BAR_WORDS 3456
#define XB_SPIN_CAP (1u << 18)

__device__ __forceinline__ unsigned xb_ld(unsigned* p)              { return __hip_atomic_load(p, __ATOMIC_RELAXED, __HIP_MEMORY_SCOPE_AGENT); }
__device__ __forceinline__ unsigned xb_add(unsigned* p, unsigned v) { return __hip_atomic_fetch_add(p, v, __ATOMIC_RELAXED, __HIP_MEMORY_SCOPE_AGENT); }
__device__ __forceinline__ unsigned xb_xcc_id() { return (unsigned)__builtin_amdgcn_s_getreg((3 << 11) | 20) & 0xFu; }
#define XB_SPIN(cond, bar) do { unsigned _sp = 0; while (cond) { __builtin_amdgcn_s_sleep(1); \
    if ((++_sp & 255u) == 0u) { if (xb_ld(&(bar)[XB_TMO])) break; if (_sp > XB_SPIN_CAP) { atomicAdd(&(bar)[XB_TMO], 1u); break; } } } } while (0)

struct XcdBarrier {
    unsigned* bar; unsigned x;
    volatile LAS unsigned* st;
};

__device__ __forceinline__ XcdBarrier xcd_barrier_post(unsigned* bar, volatile LAS unsigned* st) {
    XcdBarrier b; b.bar = bar; b.x = xb_xcc_id(); b.st = st;
    if (threadIdx.x == 0) (void)xb_add(&bar[XB_XCNT(b.x)], 1u);
    return b;
}
__device__ __forceinline__ void xcd_barrier_complete(unsigned* bar, unsigned x, unsigned& nloc, unsigned& nx) {
    const unsigned G = gridDim.x * gridDim.y * gridDim.z;
    unsigned sum, cnt, mine, sp = 0u;
    for (;;) {
        sum = 0u; cnt = 0u; mine = 0u;
#pragma unroll
        for (unsigned j = 0; j < 16; ++j) { const unsigned c = xb_ld(&bar[XB_XCNT(j)]); sum += c; cnt += (c > 0u) ? 1u : 0u; mine = (j == x) ? c : mine; }
        if (sum == G) break;
        __builtin_amdgcn_s_sleep(1);
        if ((++sp & 255u) == 0u) { if (xb_ld(&bar[XB_TMO])) break; if (sp > XB_SPIN_CAP) { atomicAdd(&bar[XB_TMO], 1u); break; } }
    }
    nloc = mine > 0u ? mine : 1u; nx = cnt > 0u ? cnt : 1u;
}

__device__ __forceinline__ void xcd_barrier(const XcdBarrier& b) {
    asm volatile("s_waitcnt vmcnt(0)" ::: "memory");
    __syncthreads();
    if (threadIdx.x == 0) {
        unsigned* bar = b.bar;
        __builtin_amdgcn_s_waitcnt(0);
        unsigned nloc = b.st[0], nx = b.st[1];
        if (nloc == 0u) { xcd_barrier_complete(bar, b.x, nloc, nx); b.st[0] = nloc; b.st[1] = nx; }
        const unsigned old = xb_add(&bar[XB_XSUB(b.x)], 1u);
        const unsigned gen = old / nloc;
        if (old + 1u == (gen + 1u) * nloc) {
            __builtin_amdgcn_fence(__ATOMIC_RELEASE, "agent");
            asm volatile("s_waitcnt vmcnt(0)" ::: "memory");
            const unsigned og = xb_add(&bar[XB_TOP], 1u);
            const unsigned tg = og / nx;
            if (og + 1u == (tg + 1u) * nx) xb_add(&bar[XB_TOPGEN], 1u);
            else XB_SPIN(xb_ld(&bar[XB_TOPGEN]) == tg, bar);
            __builtin_amdgcn_fence(__ATOMIC_ACQUIRE, "agent");
            xb_add(&bar[XB_XGEN(b.x)], 1u);
            asm volatile("s_waitcnt vmcnt(0)" ::: "memory");
        } else {
            XB_SPIN(xb_ld(&bar[XB_XGEN(b.x)]) == gen, bar);
            __builtin_amdgcn_fence(__ATOMIC_ACQUIRE, "agent");
            asm volatile("s_waitcnt vmcnt(0)" ::: "memory");
        }
    }
    __syncthreads();
}

typedef short bf16x8 __attribute__((ext_vector_type(8)));
typedef short s16x4 __attribute__((ext_vector_type(4)));
typedef float f32x16 __attribute__((ext_vector_type(16)));
typedef float f32x2 __attribute__((ext_vector_type(2)));
typedef unsigned u32x2 __attribute__((ext_vector_type(2)));
constexpr int BATCH = 4, SEQ = 4096, DM = 1024, MTOK = BATCH * SEQ, DFF = 2816, NUP = 2 * DFF;
constexpr int LDP = 6656;
constexpr int C_QA = 0, C_KA = 1024, C_QB = 2048, C_KB = 3584, C_VB = 5120, C_GATE = 3584;
constexpr float LOG2E = 1.4426950408889634f, LN_EPS = 1e-5f, ALPHA = 1.189207115002721f, QSCALE = 0.125f * LOG2E;
constexpr size_t MiB = 1u << 20;
constexpr size_t WS_WALL = 1 * MiB, WS_WPA = 20 * MiB, WS_WPB = 22 * MiB, WS_WO = 23 * MiB, WS_WUP = 25 * MiB, WS_WDN = 36 * MiB, WS_P1 = 42 * MiB;
constexpr size_t WS_Z = WS_P1, WS_F = WS_P1, WS_H = WS_P1 + 88 * MiB, WS_Z2 = WS_P1 + 88 * MiB, WS_END = 250 * MiB;
constexpr size_t OUT_XB = 0, OUT_VAT = 32 * MiB, OUT_Y = 32 * MiB, OUT_X1B = 0;
constexpr int LDS_BYTES = 160 * 1024;
constexpr int NWAVES = 8, NTHR = 512;

__device__ __forceinline__ int crow(int r, int hi) { return (r & 3) + 8 * (r >> 2) + 4 * hi; }
__device__ __forceinline__ unsigned cvtpk(float lo, float hi) { return pg8::cvt_pk_bf16(lo, hi); }
__device__ __forceinline__ float ex2(float v) { return __builtin_amdgcn_exp2f(v); }
__device__ __forceinline__ float wave_sum(float v) {
#pragma unroll
    for (int o = 1; o < 64; o <<= 1) v += __shfl_xor(v, o);
    return v;
}
#define MFMA32(a, b, c) __builtin_amdgcn_mfma_f32_32x32x16_bf16((a), (b), (c), 0, 0, 0)

__device__ __forceinline__ void transpose_item(const float* W, int K, int N, int c0, int ncols, bf16_t* WT, int row_off, float scale, LAS float* scr, int item, int lane) {
    const int nblk = ncols / 32, kb = item / nblk, nb = item % nblk, k0 = 64 * kb, n0 = 32 * nb;
#pragma unroll 8
    for (int i = 0; i < 32; ++i) { const int kk = 2 * i + (lane >> 5); scr[kk * 33 + (lane & 31)] = W[(size_t)(k0 + kk) * N + c0 + n0 + (lane & 31)] * scale; }
    asm volatile("s_waitcnt lgkmcnt(0)" ::: "memory");
    const int c = lane & 7;
#pragma unroll
    for (int j = 0; j < 4; ++j) { const int n = (lane >> 3) + 8 * j; const LAS float* s = scr + (8 * c) * 33 + n;
        u32x4 o; o.x = cvtpk(s[0 * 33], s[1 * 33]); o.y = cvtpk(s[2 * 33], s[3 * 33]); o.z = cvtpk(s[4 * 33], s[5 * 33]); o.w = cvtpk(s[6 * 33], s[7 * 33]);
        *(u32x4*)(WT + (size_t)(row_off + n0 + n) * K + k0 + 8 * c) = o; }
    asm volatile("s_waitcnt lgkmcnt(0)" ::: "memory");
}
struct Ptrs {
    const float *x, *w_in, *b_gate, *lq1, *lk1, *lq2, *lk2, *subln, *w_pa, *w_pb, *w_o, *ln1g, *ln1b, *w_up, *w_conv, *b_conv, *w_down, *ln2g, *ln2b;
    float* out; unsigned char* ws; int ph_lo, ph_hi;
};
__device__ __forceinline__ void p0_prep(const Ptrs& P, LAS unsigned char* lds, int vcu, int G, int wave, int lane, int tid) {
    LAS float* scr = (LAS float*)(lds + wave * 16384);
    const int gw = vcu * NWAVES + wave, NGW = G * NWAVES;
    bf16_t* WALL = (bf16_t*)(P.ws + WS_WALL);
    constexpr int NITEMS = 10368;
    for (int it = gw; it < NITEMS; it += NGW) {
        int r = it;
#define SEG(W, K, N, c0, nc, WT, ro, sc) { constexpr int n_ = ((K) / 64) * ((nc) / 32); if (r < n_) { transpose_item(W, K, N, c0, nc, WT, ro, sc, scr, r, lane); continue; } r -= n_; }
        SEG(P.w_in, 1024, 9728, 0, 1024, WALL, 0, QSCALE)
        SEG(P.w_in, 1024, 9728, 1024, 1024, WALL, 1024, 1.f)
        SEG(P.w_in, 1024, 9728, 2048, 1024, WALL, 6656, 1.f)
        SEG(P.w_in, 1024, 9728, 3072, 1536, WALL, 2048, QSCALE)
        SEG(P.w_in, 1024, 9728, 4608, 1536, WALL, 3584, 1.f)
        SEG(P.w_in, 1024, 9728, 6144, 1536, WALL, 5120, 1.f)
        SEG(P.w_in, 1024, 9728, 7680, 2048, WALL, 7680, 1.f)
        SEG(P.w_pa, 1024, 1024, 0, 1024, (bf16_t*)(P.ws + WS_WPA), 0, 1.f)
        SEG(P.w_pb, 512, 1024, 0, 1024, (bf16_t*)(P.ws + WS_WPB), 0, 1.f)
        SEG(P.w_o, 1024, 1024, 0, 1024, (bf16_t*)(P.ws + WS_WO), 0, 1.f)
        SEG(P.w_up, 1024, 5632, 0, 5632, (bf16_t*)(P.ws + WS_WUP), 0, 1.f)
        SEG(P.w_down, 2816, 1024, 0, 1024, (bf16_t*)(P.ws + WS_WDN), 0, 1.f)
#undef SEG
    }
    bf16_t* XB = (bf16_t*)((unsigned char*)P.out + OUT_XB);
    const size_t n8 = (size_t)MTOK * DM / 8;
    for (size_t i = (size_t)vcu * NTHR + tid; i < n8; i += (size_t)G * NTHR) {
        const f32x4 a = *(const f32x4*)(P.x + i * 8), b = *(const f32x4*)(P.x + i * 8 + 4);
        u32x4 o; o.x = cvtpk(a[0], a[1]); o.y = cvtpk(a[2], a[3]); o.z = cvtpk(b[0], b[1]); o.w = cvtpk(b[2], b[3]);
        *(u32x4*)(XB + i * 8) = o;
    }
}

namespace attA {
constexpr int KP = 272, VP = 144, KBUF = 64 * KP, VBUF = 128 * VP, BUF = KBUF + VBUF, XOFF = 2 * BUF, XP = 132;
static_assert(XOFF + 128 * XP * 4 <= LDS_BYTES, "attA lds");
__device__ __forceinline__ void unit(LAS unsigned char* lds, bf16_t* P1, const bf16_t* vaT, int b, int h, int qblk, float lam, const float* subln_w) {
    const int tid = threadIdx.x, lane = tid & 63, wid = __builtin_amdgcn_readfirstlane(tid >> 6), r32 = lane & 31, hi = lane >> 5;
    const int mi = wid >> 2, qs = wid & 3;
    const int qrow = qblk * 128 + qs * 32 + r32;
    const size_t rowbase = (size_t)b * SEQ;
    bf16x8 qf[4];
    { const bf16_t* qp = P1 + (rowbase + qrow) * LDP + C_QA + (2 * h + mi) * 64 + hi * 8;
#pragma unroll
      for (int ks = 0; ks < 4; ++ks) qf[ks] = *(const bf16x8*)(qp + ks * 16); }
    const float sl2 = ex2(-(float)(h + 1)) * LOG2E;
    f32x16 cb;
#pragma unroll
    for (int r = 0; r < 16; ++r) cb[r] = sl2 * (float)crow(r, hi);
    f32x16 O[4];
#pragma unroll
    for (int d = 0; d < 4; ++d)
#pragma unroll
        for (int r = 0; r < 16; ++r) O[d][r] = 0.f;
    float m = -INFINITY, l = 0.f;
    const int NT = 2 * qblk + 2;
    const int krow = tid >> 4, kch = tid & 15, vrow = tid >> 3, vch = tid & 7;
    const bf16_t* ksrc = P1 + (rowbase + krow) * LDP + C_KA + h * 128 + kch * 8;
    const bf16_t* vsrc = vaT + (size_t)(h * 128 + vrow) * MTOK + rowbase + vch * 8;
    const unsigned kdst = krow * KP + kch * 16, vdst = KBUF + vrow * VP + vch * 16;
    u32x4 kr0, kr1, vr0, vr1;
#define LOADT(j) { const size_t ko = (size_t)(64 * (j)) * LDP; kr0 = *(const u32x4*)(ksrc + ko); kr1 = *(const u32x4*)(ksrc + ko + (size_t)32 * LDP); \
                   vr0 = *(const u32x4*)(vsrc + 64 * (j)); vr1 = *(const u32x4*)(vsrc + (size_t)64 * MTOK + 64 * (j)); }
#define STORET(bo) { *(LAS u32x4*)(lds + (bo) + kdst) = kr0; *(LAS u32x4*)(lds + (bo) + kdst + 32 * KP) = kr1; *(LAS u32x4*)(lds + (bo) + vdst) = vr0; *(LAS u32x4*)(lds + (bo) + vdst + 64 * VP) = vr1; }
#ifndef REP_A
#define REP_A 1
#endif
#pragma unroll 1
    for (int rep_ = 0; rep_ < REP_A; ++rep_) {
    if (rep_ > 0) { m = -INFINITY; l = 0.f; for (int d = 0; d < 4; ++d) O[d] = O[d] * 0.f; __syncthreads(); }
    LOADT(NT - 1); STORET(0); __syncthreads();
    for (int jj = 0; jj < NT; ++jj) {
        const int j = NT - 1 - jj;
        const bool more = (jj + 1 < NT);
        if (more) LOADT(j - 1);
        const LAS unsigned char* kb = lds + (jj & 1) * BUF; const LAS unsigned char* vb = kb + KBUF;
        f32x16 S0 = cb, S1 = cb;
#pragma unroll
        for (int ks = 0; ks < 4; ++ks) {
            const bf16x8 a0 = *(const LAS bf16x8*)(kb + r32 * KP + mi * 128 + ks * 32 + hi * 16);
            const bf16x8 a1 = *(const LAS bf16x8*)(kb + (r32 + 32) * KP + mi * 128 + ks * 32 + hi * 16);
            S0 = MFMA32(a0, qf[ks], S0); S1 = MFMA32(a1, qf[ks], S1);
        }
        const int kv0 = 64 * j;
        if (j >= NT - 2) {
#pragma unroll
            for (int r = 0; r < 16; ++r) { const int kv = kv0 + crow(r, hi); if (kv > qrow) S0[r] = -INFINITY; if (kv + 32 > qrow) S1[r] = -INFINITY; }
        }
        const float tb0 = sl2 * (float)(kv0 - qrow), tb1 = tb0 + sl2 * 32.f;
        float mx0 = S0[0], mx1 = S1[0];
#pragma unroll
        for (int r = 1; r < 16; ++r) { mx0 = fmaxf(mx0, S0[r]); mx1 = fmaxf(mx1, S1[r]); }
        float mt = fmaxf(mx0 + tb0, mx1 + tb1); mt = fmaxf(mt, __shfl_xor(mt, 32));
        const bool skip = __all((mt < m - 40.f) || (mt == -INFINITY));
        if (!skip) {
        const float mn = fmaxf(m, mt); const float alpha = ex2(m - mn); m = mn;
        const float c0 = tb0 - mn, c1 = tb1 - mn;
        float ps = 0.f;
#pragma unroll
        for (int r = 0; r < 16; ++r) { S0[r] = ex2(S0[r] + c0); S1[r] = ex2(S1[r] + c1); ps += S0[r] + S1[r]; }
        l = l * alpha + ps;
        if (__any(alpha != 1.f)) {
#pragma unroll
            for (int d = 0; d < 4; ++d) O[d] = O[d] * alpha;
        }
        u32x4 pk[2][2];
#pragma unroll
        for (int s = 0; s < 2; ++s) {
            pk[0][s] = (u32x4){cvtpk(S0[8 * s + 0], S0[8 * s + 1]), cvtpk(S0[8 * s + 2], S0[8 * s + 3]), cvtpk(S0[8 * s + 4], S0[8 * s + 5]), cvtpk(S0[8 * s + 6], S0[8 * s + 7])};
            pk[1][s] = (u32x4){cvtpk(S1[8 * s + 0], S1[8 * s + 1]), cvtpk(S1[8 * s + 2], S1[8 * s + 3]), cvtpk(S1[8 * s + 4], S1[8 * s + 5]), cvtpk(S1[8 * s + 6], S1[8 * s + 7])};
        }
#pragma unroll
        for (int d = 0; d < 4; ++d)
#pragma unroll
            for (int t2 = 0; t2 < 2; ++t2)
#pragma unroll
                for (int s = 0; s < 2; ++s) {
                    const LAS unsigned char* vp = vb + (d * 32 + r32) * VP + (t2 * 32 + s * 16 + hi * 4) * 2;
                    const s16x4 lo = *(const LAS s16x4*)vp, hh = *(const LAS s16x4*)(vp + 16);
                    const bf16x8 vf = (bf16x8){lo[0], lo[1], lo[2], lo[3], hh[0], hh[1], hh[2], hh[3]};
                    O[d] = MFMA32(vf, __builtin_bit_cast(bf16x8, pk[t2][s]), O[d]);
                }
        }
        if (more) STORET(((jj + 1) & 1) * BUF);
        __syncthreads();
    }
    }
#undef LOADT
#undef STORET
    const float lt = l + __shfl_xor(l, 32); const float inv = 1.f / lt;
    LAS float* X = (LAS float*)(lds + XOFF);
    const int ql = qs * 32 + r32;
    if (mi == 1) { const float sc = inv * lam;
#pragma unroll
        for (int d = 0; d < 4; ++d)
#pragma unroll
            for (int g4 = 0; g4 < 4; ++g4) { const f32x4 v = (f32x4){O[d][4 * g4], O[d][4 * g4 + 1], O[d][4 * g4 + 2], O[d][4 * g4 + 3]} * sc;
                *(LAS f32x4*)(X + ql * XP + d * 32 + g4 * 8 + hi * 4) = v; } }
    __syncthreads();
    if (mi == 0) { float ss = 0.f;
#pragma unroll
        for (int d = 0; d < 4; ++d)
#pragma unroll
            for (int g4 = 0; g4 < 4; ++g4) { const f32x4 xv = *(const LAS f32x4*)(X + ql * XP + d * 32 + g4 * 8 + hi * 4);
#pragma unroll
                for (int e = 0; e < 4; ++e) { const float dv = O[d][4 * g4 + e] * inv - xv[e]; O[d][4 * g4 + e] = dv; ss += dv * dv; } }
        ss += __shfl_xor(ss, 32);
        const float rinv = rsqrtf(ss * (1.f / 128.f) + LN_EPS) * 0.8f;
        bf16_t* op = P1 + (rowbase + qrow) * LDP + C_QA + h * 128;
#pragma unroll
        for (int d = 0; d < 4; ++d)
#pragma unroll
            for (int g4 = 0; g4 < 4; ++g4) { const int d0 = d * 32 + g4 * 8 + hi * 4; const f32x4 w = *(const f32x4*)(subln_w + d0);
                u32x2 o; o.x = cvtpk(O[d][4 * g4] * rinv * w[0], O[d][4 * g4 + 1] * rinv * w[1]); o.y = cvtpk(O[d][4 * g4 + 2] * rinv * w[2], O[d][4 * g4 + 3] * rinv * w[3]);
                *(u32x2*)(op + d0) = o; } }
    __syncthreads();
}
}

namespace attB {
__device__ __forceinline__ void unit(LAS unsigned char* lds, bf16_t* P1, int b, int h, int chunk) {
    LAS float* Os = (LAS float*)lds; LAS float* Ms = (LAS float*)(lds + 131072); LAS float* Ls = Ms + 512;
    const int tid = threadIdx.x, lane = tid & 63, wid = __builtin_amdgcn_readfirstlane(tid >> 6), r32 = lane & 31, hi = lane >> 5;
    const int t0 = chunk * 512; const size_t rowbase = (size_t)b * SEQ;
    const float sl2 = ex2(-(float)(h + 1)) * LOG2E;
    for (int g = 0; g < 3; ++g) {
        const int sh = 2 * g; const float sd = sl2 * (float)(1 << sh);
        f32x16 cb;
#pragma unroll
        for (int r = 0; r < 16; ++r) cb[r] = sd * (float)crow(r, hi);
        for (int wt = wid; wt < 16; wt += 8) {
            const int cls = wt >> (4 - sh), sub = wt & ((16 >> sh) - 1);
            const int i0 = (t0 >> sh) + 32 * sub, iq = i0 + r32, tq = (iq << sh) + cls;
            bf16x8 qf[4];
            { const bf16_t* qp = P1 + (rowbase + tq) * LDP + C_QB + g * 512 + h * 64 + hi * 8;
#pragma unroll
              for (int ks = 0; ks < 4; ++ks) qf[ks] = *(const bf16x8*)(qp + ks * 16); }
            f32x16 O[2];
#pragma unroll
            for (int r = 0; r < 16; ++r) { O[0][r] = 0.f; O[1][r] = 0.f; }
            float m = -INFINITY, l = 0.f;
#ifndef REP_B
#define REP_B 1
#endif
#pragma unroll 1
            for (int rep_ = 0; rep_ < REP_B; ++rep_) {
            if (rep_ > 0) { m = -INFINITY; l = 0.f; O[0] = O[0] * 0.f; O[1] = O[1] * 0.f; }
            for (int kb = 0; kb < 5; ++kb) {
                const int ib = i0 - 128 + 32 * kb; if (ib < 0) continue;
                const int tk = ((ib + r32) << sh) + cls;
                const bf16_t* kp = P1 + (rowbase + tk) * LDP + C_KB + g * 512 + h * 64 + hi * 8;
                f32x16 S = cb;
#pragma unroll
                for (int ks = 0; ks < 4; ++ks) S = MFMA32(*(const bf16x8*)(kp + ks * 16), qf[ks], S);
                if (kb == 0) {
#pragma unroll
                    for (int r = 0; r < 16; ++r) { const int ik = ib + crow(r, hi); if (iq - ik > 128) S[r] = -INFINITY; } }
                if (kb == 4) {
#pragma unroll
                    for (int r = 0; r < 16; ++r) { const int ik = ib + crow(r, hi); if (ik > iq) S[r] = -INFINITY; } }
                const float tb = sd * (float)(ib - iq);
                float mx = S[0];
#pragma unroll
                for (int r = 1; r < 16; ++r) mx = fmaxf(mx, S[r]);
                float mt = mx + tb; mt = fmaxf(mt, __shfl_xor(mt, 32));
                const float mn = fmaxf(m, mt); const float alpha = ex2(m - mn); m = mn; const float c = tb - mn;
                float ps = 0.f;
#pragma unroll
                for (int r = 0; r < 16; ++r) { S[r] = ex2(S[r] + c); ps += S[r]; }
                l = l * alpha + ps; O[0] = O[0] * alpha; O[1] = O[1] * alpha;
                u32x4 pk[2];
#pragma unroll
                for (int s = 0; s < 2; ++s) pk[s] = (u32x4){cvtpk(S[8 * s + 0], S[8 * s + 1]), cvtpk(S[8 * s + 2], S[8 * s + 3]), cvtpk(S[8 * s + 4], S[8 * s + 5]), cvtpk(S[8 * s + 6], S[8 * s + 7])};
                const bf16_t* vbase = P1 + rowbase * LDP + C_VB + g * 512 + h * 64 + r32;
#pragma unroll
                for (int d = 0; d < 2; ++d)
#pragma unroll
                    for (int s = 0; s < 2; ++s) {
                        bf16x8 vf;
#pragma unroll
                        for (int j = 0; j < 8; ++j) { const int kvl = 16 * s + 8 * (j >> 2) + 4 * hi + (j & 3); const int tok = ((ib + kvl) << sh) + cls;
                            vf[j] = (short)vbase[(size_t)tok * LDP + d * 32]; }
                        O[d] = MFMA32(vf, __builtin_bit_cast(bf16x8, pk[s]), O[d]);
                    }
            }
            }
            const float lt = l + __shfl_xor(l, 32); const int tl = tq - t0;
            float a_new = 1.f, a_old = 0.f, Ln = lt;
            if (g > 0) { const float mo = Ms[tl], lo = Ls[tl]; const float mn = fmaxf(mo, m); a_old = ex2(mo - mn); a_new = ex2(m - mn); Ln = lo * a_old + lt * a_new; m = mn; }
            if (g < 2 && hi == 0) { Ms[tl] = m; Ls[tl] = Ln; }
            const float invL = 1.f / Ln;
            bf16_t* op = P1 + (rowbase + tq) * LDP + C_QB + h * 64;
#pragma unroll
            for (int d = 0; d < 2; ++d)
#pragma unroll
                for (int g4 = 0; g4 < 4; ++g4) { const int ch = 2 * g4 + hi + 8 * d; LAS f32x4* p = (LAS f32x4*)(Os + tl * 64 + ((ch ^ (tl & 15)) << 2));
                    f32x4 v = (f32x4){O[d][4 * g4], O[d][4 * g4 + 1], O[d][4 * g4 + 2], O[d][4 * g4 + 3]} * a_new;
                    if (g > 0) v = v + (*p) * a_old;
                    if (g < 2) *p = v;
                    else { v = v * invL; u32x2 o; o.x = cvtpk(v[0], v[1]); o.y = cvtpk(v[2], v[3]); *(u32x2*)(op + ch * 4) = o; } }
        }
        __syncthreads();
    }
}
}

__device__ __forceinline__ void ln_rows(const float* Z, const float* gam, const float* bet, bf16_t* outb, float* outf, int gw, int NGW, int lane) {
    for (int mrow = gw; mrow < MTOK; mrow += NGW) {
        const f32x4* zr = (const f32x4*)(Z + (size_t)mrow * DM) + lane;
        f32x4 v[4]; float s = 0.f;
#pragma unroll
        for (int j = 0; j < 4; ++j) { v[j] = zr[64 * j]; s += (v[j][0] + v[j][1]) + (v[j][2] + v[j][3]); }
        const float mean = wave_sum(s) * (1.f / DM); float s2 = 0.f;
#pragma unroll
        for (int j = 0; j < 4; ++j) { v[j] = v[j] - mean; s2 += (v[j][0] * v[j][0] + v[j][1] * v[j][1]) + (v[j][2] * v[j][2] + v[j][3] * v[j][3]); }
        const float rstd = rsqrtf(wave_sum(s2) * (1.f / DM) + LN_EPS);
#pragma unroll
        for (int j = 0; j < 4; ++j) { const int c = 4 * (lane + 64 * j); const f32x4 g4 = *(const f32x4*)(gam + c), b4 = *(const f32x4*)(bet + c);
            const f32x4 o = v[j] * rstd * g4 + b4;
            if (outb) { u32x2 w; w.x = cvtpk(o[0], o[1]); w.y = cvtpk(o[2], o[3]); *(u32x2*)(outb + (size_t)mrow * DM + c) = w; }
            if (outf) *(f32x4*)(outf + (size_t)mrow * DM + c) = o; }
    }
}

__device__ __forceinline__ void unpack8(const u32x4 w, float (&f)[8]) {
    f[0] = pg8::bf_lo(w.x); f[1] = pg8::bf_hi(w.x); f[2] = pg8::bf_lo(w.y); f[3] = pg8::bf_hi(w.y); f[4] = pg8::bf_lo(w.z); f[5] = pg8::bf_hi(w.z); f[6] = pg8::bf_lo(w.w); f[7] = pg8::bf_hi(w.w); }
__device__ __forceinline__ void conv_geglu_half(const bf16_t* H, bf16_t* F, const float* wc, const float* bc, int half, int gt, int NGT) {
    constexpr int NCC = DFF / 8, RUN = 16, NITEM = (MTOK / 2 / RUN) * NCC;
    for (int it = gt; it < NITEM; it += NGT) {
        const int rc = it / NCC, cc = it % NCC, r0 = rc * RUN, c = cc * 8;
        float w0a[8], w1a[8], w2a[8], ba[8], w0g[8], w1g[8], w2g[8], bg[8];
#pragma unroll
        for (int e = 0; e < 8; ++e) { w0a[e] = wc[c + e]; w1a[e] = wc[NUP + c + e]; w2a[e] = wc[2 * NUP + c + e]; ba[e] = bc[c + e];
            w0g[e] = wc[DFF + c + e]; w1g[e] = wc[NUP + DFF + c + e]; w2g[e] = wc[2 * NUP + DFF + c + e]; bg[e] = bc[DFF + c + e]; }
        float p2a[8], p1a[8], p2g[8], p1g[8];
        if ((r0 & (SEQ - 1)) == 0) {
#pragma unroll
            for (int e = 0; e < 8; ++e) { p2a[e] = 0.f; p1a[e] = 0.f; p2g[e] = 0.f; p1g[e] = 0.f; }
        } else {
            unpack8(*(const u32x4*)(H + (size_t)(r0 - 2) * NUP + c), p2a); unpack8(*(const u32x4*)(H + (size_t)(r0 - 1) * NUP + c), p1a);
            unpack8(*(const u32x4*)(H + (size_t)(r0 - 2) * NUP + DFF + c), p2g); unpack8(*(const u32x4*)(H + (size_t)(r0 - 1) * NUP + DFF + c), p1g);
        }
#pragma unroll 4
        for (int i = 0; i < RUN; ++i) {
            float ca[8], cgv[8];
            unpack8(*(const u32x4*)(H + (size_t)(r0 + i) * NUP + c), ca); unpack8(*(const u32x4*)(H + (size_t)(r0 + i) * NUP + DFF + c), cgv);
            float o[8];
#pragma unroll
            for (int e = 0; e < 8; e += 2) {
                const f32x2 av = (f32x2){ba[e] + w0a[e] * p2a[e] + w1a[e] * p1a[e] + w2a[e] * ca[e], ba[e + 1] + w0a[e + 1] * p2a[e + 1] + w1a[e + 1] * p1a[e + 1] + w2a[e + 1] * ca[e + 1]};
                const f32x2 ge = pg8::gelu_pk(av);
                o[e] = ge.x * (bg[e] + w0g[e] * p2g[e] + w1g[e] * p1g[e] + w2g[e] * cgv[e]);
                o[e + 1] = ge.y * (bg[e + 1] + w0g[e + 1] * p2g[e + 1] + w1g[e + 1] * p1g[e + 1] + w2g[e + 1] * cgv[e + 1]);
            }
            u32x4 w; w.x = cvtpk(o[0], o[1]); w.y = cvtpk(o[2], o[3]); w.z = cvtpk(o[4], o[5]); w.w = cvtpk(o[6], o[7]);
            *(u32x4*)(F + (size_t)(half * (MTOK / 2) + r0 + i) * DFF + c) = w;
#pragma unroll
            for (int e = 0; e < 8; ++e) { p2a[e] = p1a[e]; p1a[e] = ca[e]; p2g[e] = p1g[e]; p1g[e] = cgv[e]; }
        }
    }
}

#ifndef MK_SPLIT
#define MK_SPLIT 0
#endif
constexpr int NPHASE = 12;
__global__ void __launch_bounds__(NTHR, 2) fwd_kernel(Ptrs P) {
    extern __shared__ __attribute__((aligned(16))) unsigned char lds_raw[];
    LAS unsigned char* lds = (LAS unsigned char*)lds_raw;
    const int tid = threadIdx.x, lane = tid & 63, wave = __builtin_amdgcn_readfirstlane(tid >> 6);
    const int G = gridDim.x, bx = blockIdx.x;
    const int vcu = (G % 8 == 0) ? (bx % 8) * (G / 8) + bx / 8 : bx;
    unsigned char* ws = P.ws; unsigned char* ob = (unsigned char*)P.out;
    bf16_t* WALL = (bf16_t*)(ws + WS_WALL); bf16_t* P1 = (bf16_t*)(ws + WS_P1);
    bf16_t* XB = (bf16_t*)(ob + OUT_XB); bf16_t* VAT = (bf16_t*)(ob + OUT_VAT); bf16_t* Y = (bf16_t*)(ob + OUT_Y); bf16_t* X1B = (bf16_t*)(ob + OUT_X1B);
    const int lo = P.ph_lo, hi = P.ph_hi;
    volatile LAS unsigned* bst = (volatile LAS unsigned*)(lds + LDS_BYTES - 64);
    if (tid < 2) bst[tid] = 0u;
    __syncthreads();
    (void)xcd_barrier_post((unsigned*)(ws + 4096), bst);
    if (hi > 1000) cg::this_grid().sync();
#ifndef PHMASK
#define PHMASK 0xfff
#endif
#define IN(k) (((PHMASK >> (k)) & 1) && lo <= (k) && (k) < hi)
#ifndef REPMASK
#define REPMASK 0
#endif
#ifndef XSYNC
#define XSYNC 0
#endif
#if REPMASK
#define RPT(k) _Pragma("unroll 1") for (int rp_ = 0; rp_ < 1 + ((REPMASK >> (k)) & 1); ++rp_)
#else
#define RPT(k)
#endif
#if MK_SPLIT
#define SEAM(k) do {} while (0)
#else
#define XBAR() do { XcdBarrier xb_; xb_.bar = (unsigned*)(P.ws + 4096); xb_.x = xb_xcc_id(); xb_.st = (volatile LAS unsigned*)(lds + LDS_BYTES - 64); xcd_barrier(xb_); } while (0)
#define SEAM(k) do { if (IN(k) && IN((k) + 1)) XBAR(); } while (0)
#endif
    using namespace pg8;
#if XSYNC
    for (int xs_ = 0; xs_ < XSYNC; ++xs_) XBAR();
#endif
    RPT(0) if (IN(0)) { p0_prep(P, lds, vcu, G, wave, lane, tid); }
    SEAM(0);
    RPT(1) if (IN(1)) {
        { Gemm g{XB, WALL, MTOK, LDP, DM, DM, DM}; StaticOrder S; S.init(MTOK, LDP, G, bx);
          EpiStore<0> E{P1, LDP, nullptr};
          gemm_phase<EpiStore<0>, StaticOrder, true, true>(lds, g, S, E); }
        { Gemm g{WALL + (size_t)6656 * DM, XB, 1024, MTOK, DM, DM, DM}; StaticOrder S; S.init(1024, MTOK, G, bx);
          EpiStore<0> E{VAT, MTOK, nullptr};
          gemm_phase<EpiStore<0>, StaticOrder, true, true>(lds, g, S, E); }
    }
    SEAM(1);
    if (IN(2)) {
        float lam;
        { const float a = P.lq1[lane] * P.lk1[lane], b2 = P.lq2[lane] * P.lk2[lane]; lam = expf(wave_sum(a)) - expf(wave_sum(b2)) + 0.2f; }
        __syncthreads();
#pragma unroll 1
        for (int u = vcu; u < 256; u += G) attB::unit(lds, P1, u >> 6, (u >> 3) & 7, u & 7);
        volatile LAS int* qslot = (volatile LAS int*)(lds + LDS_BYTES - 16);
#pragma unroll 1
        for (;;) {
            if (tid == 0) *qslot = (int)atomicAdd((unsigned*)(ws + 64), 1u);
            __syncthreads();
            const int idx = *qslot;
            __syncthreads();
            if (idx >= 1024) break;
            const int b = idx & 3, r = idx >> 2, qblk = 31 - (r & 31), h = 7 - (r >> 5);
            attA::unit(lds, P1, VAT, b, h, qblk, lam, P.subln);
        }
    }
    SEAM(2);
    RPT(3) if (IN(3)) {
        { Gemm g{XB, WALL + (size_t)7680 * DM, MTOK, 2048, DM, DM, DM}; GateOrder S; S.S.init(MTOK, DM, G, bx);
          EpiStore<2> E{P1 + C_GATE, LDP, P.b_gate};
          gemm_phase<EpiStore<2>, GateOrder, true, true>(lds, g, S, E); }
        asm volatile("s_waitcnt vmcnt(0)" ::: "memory"); __syncthreads();
        { Gemm g{P1 + C_QA, (const bf16_t*)(ws + WS_WPA), MTOK, DM, 1024, LDP, 1024}; StaticOrder S; S.init(MTOK, DM, G, bx);
          EpiMix<false> E{Y, DM, P1 + C_GATE, LDP, nullptr, 0};
          gemm_phase<EpiMix<false>, StaticOrder, true, true>(lds, g, S, E); }
        asm volatile("s_waitcnt vmcnt(0)" ::: "memory"); __syncthreads();
        { Gemm g{P1 + C_QB, (const bf16_t*)(ws + WS_WPB), MTOK, DM, 512, LDP, 512}; StaticOrder S; S.init(MTOK, DM, G, bx);
          EpiMix<true> E{Y, DM, P1 + C_GATE + 1024, LDP, Y, DM};
          gemm_phase<EpiMix<true>, StaticOrder, true, true>(lds, g, S, E); }
    }
    SEAM(3);
    RPT(4) if (IN(4)) {
        Gemm g{Y, (const bf16_t*)(ws + WS_WO), MTOK, DM, DM, DM, DM}; StaticOrder S; S.init(MTOK, DM, G, bx);
        EpiRes<false> E{(float*)(ws + WS_Z), DM, P.x, ALPHA};
        gemm_phase<EpiRes<false>, StaticOrder, true, true>(lds, g, S, E);
    }
    SEAM(4);
    RPT(5) if (IN(5)) { ln_rows((const float*)(ws + WS_Z), P.ln1g, P.ln1b, X1B, nullptr, vcu * NWAVES + wave, G * NWAVES, lane); }
    SEAM(5);
#define half 0

        RPT(6) if (IN(6 + 2 * half)) {
            Gemm g{X1B + (size_t)half * (MTOK / 2) * DM, (const bf16_t*)(ws + WS_WUP), MTOK / 2, NUP, DM, DM, DM}; StaticOrder S; S.init(MTOK / 2, NUP, G, bx);
            EpiStore<0> E{(bf16_t*)(ws + WS_H), NUP, nullptr};
            gemm_phase<EpiStore<0>, StaticOrder, true, true>(lds, g, S, E);
        }
        SEAM(6 + 2 * half);
        RPT(7) if (IN(7 + 2 * half)) { conv_geglu_half((const bf16_t*)(ws + WS_H), (bf16_t*)(ws + WS_F), P.w_conv, P.b_conv, half, vcu * NTHR + tid, G * NTHR); }
        SEAM(7 + 2 * half);
    #undef half
#define half 1

        RPT(6) if (IN(6 + 2 * half)) {
            Gemm g{X1B + (size_t)half * (MTOK / 2) * DM, (const bf16_t*)(ws + WS_WUP), MTOK / 2, NUP, DM, DM, DM}; StaticOrder S; S.init(MTOK / 2, NUP, G, bx);
            EpiStore<0> E{(bf16_t*)(ws + WS_H), NUP, nullptr};
            gemm_phase<EpiStore<0>, StaticOrder, true, true>(lds, g, S, E);
        }
        SEAM(6 + 2 * half);
        RPT(7) if (IN(7 + 2 * half)) { conv_geglu_half((const bf16_t*)(ws + WS_H), (bf16_t*)(ws + WS_F), P.w_conv, P.b_conv, half, vcu * NTHR + tid, G * NTHR); }
        SEAM(7 + 2 * half);
    #undef half
    RPT(10) if (IN(10)) {
        Gemm g{(const bf16_t*)(ws + WS_F), (const bf16_t*)(ws + WS_WDN), MTOK, DM, DFF, DFF, DFF}; StaticOrder S; S.init(MTOK, DM, G, bx);
        EpiRes<true> E{(float*)(ws + WS_Z2), DM, X1B, ALPHA};
        gemm_phase<EpiRes<true>, StaticOrder, true, true>(lds, g, S, E);
    }
    SEAM(10);
    RPT(11) if (IN(11)) { ln_rows((const float*)(ws + WS_Z2), P.ln2g, P.ln2b, nullptr, P.out, vcu * NWAVES + wave, G * NWAVES, lane); }
#undef IN
#undef SEAM
}

extern "C" void kernel_launch(void* const* d_in, const int* in_sizes, int n_in, void* d_out, int out_size, void* d_ws, size_t ws_size, hipStream_t stream) {
    static int grid = 0;
    if (grid == 0) {
        if (n_in != 19 || out_size != MTOK * DM || ws_size < WS_END) { fprintf(stderr, "kernel_launch: unexpected shapes (n_in %d out %d ws %zu)\n", n_in, out_size, ws_size); grid = -1; return; }
        int dev = 0, cus = 0, per_cu = 0;
        hipGetDevice(&dev); hipDeviceGetAttribute(&cus, hipDeviceAttributeMultiprocessorCount, dev);
        if (hipFuncSetAttribute((const void*)fwd_kernel, hipFuncAttributeMaxDynamicSharedMemorySize, LDS_BYTES) != hipSuccess) { fprintf(stderr, "kernel_launch: hipFuncSetAttribute failed\n"); grid = -1; return; }
        if (hipOccupancyMaxActiveBlocksPerMultiprocessor(&per_cu, (const void*)fwd_kernel, NTHR, LDS_BYTES) != hipSuccess || per_cu < 1) { fprintf(stderr, "kernel_launch: occupancy query gives %d\n", per_cu); per_cu = 1; }
        (void)hipGetLastError();
        grid = cus * 1;
        if (grid > 256) grid = 256;
    }
    if (grid < 0) return;
    Ptrs p{};
    const float** pp = (const float**)&p;
    for (int i = 0; i < 19; ++i) pp[i] = (const float*)d_in[i];
    p.out = (float*)d_out; p.ws = (unsigned char*)d_ws;
#if MK_SPLIT
    for (int k = 0; k < NPHASE; ++k) { p.ph_lo = k; p.ph_hi = k + 1; hipLaunchKernelGGL(fwd_kernel, dim3(grid), dim3(NTHR), LDS_BYTES, stream, p); }
#else
    p.ph_lo = 0; p.ph_hi = NPHASE;
    (void)hipMemsetAsync(d_ws, 0, 65536, stream);
    void* args[] = {&p};
    hipError_t e = hipLaunchCooperativeKernel((const void*)fwd_kernel, dim3(grid), dim3(NTHR), args, LDS_BYTES, stream);
    if (e != hipSuccess) fprintf(stderr, "cooperative launch failed: %s (grid %d)\n", hipGetErrorString(e), grid);
#endif
}
```
